# Optimizing an MI355X kernel written in HIP

```python
import math
import jax, jax.numpy as jnp
from jax import lax
import numpy as np

D_MODEL = 1024
BATCH = 8
SEQ = 2048
DEPTH = 2

N_MIXERS = 2
HEAD_DIM = 128
N_MAIN_HEADS = 12
N_MEM_HEADS = 4
N_MEM = 256
INNER = (N_MAIN_HEADS + N_MEM_HEADS) * HEAD_DIM
MAIN_W = N_MAIN_HEADS * HEAD_DIM
MEM_W = N_MEM_HEADS * HEAD_DIM
RET_KEY_DIM = HEAD_DIM // 2
BLOCK_Q = 128
RET_CHUNK = 128
ROPE_BASE = 10000.0
EPS = 1e-6
NEG = -1e30
FOX_IN = 3 * MAIN_W + N_MAIN_HEADS + MEM_W + INNER
RET_IN = 2 * N_MAIN_HEADS * RET_KEY_DIM + MAIN_W + MEM_W + INNER
N_FOX = len(range(0, DEPTH, N_MIXERS))
N_RET = len(range(1, DEPTH, N_MIXERS))

kernel_name = "fox_retention_interleaved_hybrid"


def rmsnorm(x, g):
    xf = x.astype(jnp.float32)
    y = xf * lax.rsqrt(jnp.mean(xf * xf, axis=-1, keepdims=True) + EPS)
    return (y * g.astype(jnp.float32)).astype(x.dtype)


def split_cols(t, sizes):
    idx = list(np.cumsum(sizes)[:-1])
    return jnp.split(t, idx, axis=-1)


def rotary(t, pos):
    half = t.shape[-1] // 2
    inv = 1.0 / (ROPE_BASE ** (jnp.arange(half, dtype=jnp.float32) / half))
    ang = pos[:, None] * inv[None, :]
    cos = jnp.cos(ang)[None, :, None, :].astype(t.dtype)
    sin = jnp.sin(ang)[None, :, None, :].astype(t.dtype)
    t1, t2 = t[..., :half], t[..., half:]
    return jnp.concatenate([t1 * cos - t2 * sin, t1 * sin + t2 * cos], axis=-1)


def fox_attention(q, k, v, f_logit, b_f):
    B, S, _ = q.shape
    H, d = N_MAIN_HEADS, HEAD_DIM
    q = q.reshape(B, S, H, d).transpose(0, 2, 1, 3)
    k = k.reshape(B, S, H, d).transpose(0, 2, 1, 3)
    v = v.reshape(B, S, H, d).transpose(0, 2, 1, 3)
    log_f = jax.nn.log_sigmoid(f_logit.astype(jnp.float32) + b_f.astype(jnp.float32))
    c = jnp.cumsum(log_f, axis=1).transpose(0, 2, 1)
    nb = S // BLOCK_Q
    qb = q.reshape(B, H, nb, BLOCK_Q, d).transpose(2, 0, 1, 3, 4)
    cb = c.reshape(B, H, nb, BLOCK_Q).transpose(2, 0, 1, 3)
    starts = jnp.arange(nb, dtype=jnp.int32) * BLOCK_Q
    key_pos = jnp.arange(S, dtype=jnp.int32)
    scale = 1.0 / math.sqrt(d)

    def block(args):
        qi, ci, st = args
        qpos = st + jnp.arange(BLOCK_Q, dtype=jnp.int32)
        s = jnp.einsum('bhqd,bhkd->bhqk', qi, k).astype(jnp.float32) * scale
        s = s + ci[..., None] - c[:, :, None, :]
        mask = key_pos[None, :] <= qpos[:, None]
        s = jnp.where(mask[None, None], s, NEG)
        p = jax.nn.softmax(s, axis=-1).astype(v.dtype)
        return jnp.einsum('bhqk,bhkd->bhqd', p, v)

    out = lax.map(block, (qb, cb, starts))
    return out.transpose(1, 0, 3, 2, 4).reshape(B, S, H * d)


def retention(q, k, v):
    B, S, _ = q.shape
    H, dk, dv, C = N_MAIN_HEADS, RET_KEY_DIM, HEAD_DIM, RET_CHUNK
    pos = jnp.arange(S, dtype=jnp.float32)
    qf = rotary(q.reshape(B, S, H, dk).astype(jnp.float32), pos)
    kf = rotary(k.reshape(B, S, H, dk).astype(jnp.float32), pos) * (dk ** -0.5)
    vf = v.reshape(B, S, H, dv).astype(jnp.float32)
    lg = jnp.log1p(-jnp.exp2(-5.0 - jnp.arange(H, dtype=jnp.float32)))
    n = jnp.arange(C, dtype=jnp.float32)
    diff = n[:, None] - n[None, :]
    d_inner = jnp.where(diff[None] >= 0, jnp.exp(lg[:, None, None] * jnp.maximum(diff, 0.0)[None]), 0.0)
    xi = jnp.exp(lg[:, None] * (n[None, :] + 1.0))
    zeta = jnp.exp(lg[:, None] * (C - 1.0 - n[None, :]))
    g_chunk = jnp.exp(lg * C)
    nc = S // C

    def to_chunks(t):
        return t.reshape(B, nc, C, H, t.shape[-1]).transpose(1, 0, 3, 2, 4)

    def step(R, xs):
        qc, kc, vc = xs
        inner = jnp.einsum('bhnd,bhmd->bhnm', qc, kc) * d_inner[None]
        o = jnp.einsum('bhnm,bhme->bhne', inner, vc)
        o = o + jnp.einsum('bhnd,bhde->bhne', qc, R) * xi[None, :, :, None]
        R = g_chunk[None, :, None, None] * R + jnp.einsum('bhmd,bhme->bhde', kc * zeta[None, :, :, None], vc)
        return R, o

    R0 = jnp.zeros((B, H, dk, dv), jnp.float32)
    _, out = lax.scan(step, R0, (to_chunks(qf), to_chunks(kf), to_chunks(vf)))
    out = out.transpose(1, 0, 3, 2, 4).reshape(B, S, H, dv)
    out = out * lax.rsqrt(jnp.mean(out * out, axis=-1, keepdims=True) + EPS)
    return out.reshape(B, S, H * dv).astype(q.dtype)


def mem_cross_attention(q_mem, mem_n, w_kv):
    B, S, _ = q_mem.shape
    kv = mem_n @ w_kv
    km, vm = split_cols(kv, [MEM_W, MEM_W])
    q = q_mem.reshape(B, S, N_MEM_HEADS, HEAD_DIM)
    km = km.reshape(B, -1, N_MEM_HEADS, HEAD_DIM)
    vm = vm.reshape(B, -1, N_MEM_HEADS, HEAD_DIM)
    s = jnp.einsum('bshd,bmhd->bhsm', q, km).astype(jnp.float32) / math.sqrt(HEAD_DIM)
    p = jax.nn.softmax(s, axis=-1).astype(vm.dtype)
    return jnp.einsum('bhsm,bmhd->bshd', p, vm).reshape(B, S, MEM_W)


def setup_inputs(seed: int = 0) -> dict:
    key = jax.random.key(seed)
    ks = jax.random.split(key, 10)
    f32 = jnp.float32
    x = jax.random.normal(ks[0], (BATCH, SEQ, D_MODEL), f32)
    mem = jax.random.normal(ks[1], (BATCH, N_MEM, D_MODEL), f32)
    norm_g = 1.0 + 0.02 * jax.random.normal(ks[2], (DEPTH, D_MODEL), f32)
    fox_w_in = jax.random.normal(ks[3], (N_FOX, D_MODEL, FOX_IN), f32) * D_MODEL ** -0.5
    fox_b_f = 3.0 + 0.5 * jax.random.normal(ks[4], (N_FOX, N_MAIN_HEADS), f32)
    ret_w_in = jax.random.normal(ks[5], (N_RET, D_MODEL, RET_IN), f32) * D_MODEL ** -0.5
    mem_norm_g = 1.0 + 0.02 * jax.random.normal(ks[6], (D_MODEL,), f32)
    w_mem_kv = jax.random.normal(ks[7], (DEPTH, D_MODEL, 2 * MEM_W), f32) * D_MODEL ** -0.5
    w_out = jax.random.normal(ks[8], (DEPTH, INNER, D_MODEL), f32) * INNER ** -0.5
    final_norm_g = 1.0 + 0.02 * jax.random.normal(ks[9], (D_MODEL,), f32)
    return {"x": x, "mem": mem, "norm_g": norm_g, "fox_w_in": fox_w_in, "fox_b_f": fox_b_f,
            "ret_w_in": ret_w_in, "mem_norm_g": mem_norm_g, "w_mem_kv": w_mem_kv,
            "w_out": w_out, "final_norm_g": final_norm_g}


def reference(x, mem, norm_g, fox_w_in, fox_b_f, ret_w_in, mem_norm_g, w_mem_kv, w_out, final_norm_g):
    mem_n = rmsnorm(mem, mem_norm_g)
    for i in range(DEPTH):
        h = rmsnorm(x, norm_g[i])
        j = i // N_MIXERS
        if i % N_MIXERS == 0:
            proj = h @ fox_w_in[j]
            q, k, v, f_logit, q_mem, z = split_cols(
                proj, [MAIN_W, MAIN_W, MAIN_W, N_MAIN_HEADS, MEM_W, INNER])
            main = fox_attention(q, k, v, f_logit, fox_b_f[j])
        else:
            proj = h @ ret_w_in[j]
            qk_w = N_MAIN_HEADS * RET_KEY_DIM
            q, k, v, q_mem, z = split_cols(proj, [qk_w, qk_w, MAIN_W, MEM_W, INNER])
            main = retention(q, k, v)
        memo = mem_cross_attention(q_mem, mem_n, w_mem_kv[i])
        o = jnp.concatenate([main, memo], axis=-1) * jax.nn.silu(z)
        x = x + o @ w_out[i]
    return rmsnorm(x, final_norm_g)
```

```cpp
#include <hip/hip_runtime.h>
#include <hip/hip_bf16.h>
#include <hip/hip_cooperative_groups.h>
#include <cstdio>
#include <cstdint>
namespace cg = cooperative_groups;

#ifndef MK_MULTI_LAUNCH
#define MK_MULTI_LAUNCH 0
#endif

constexpr int NB = 8, SEQ = 2048, DM = 1024, MROWS = NB * SEQ;
constexpr int NH = 12, NHM = 4, HD = 128, NMEM = 256;
constexpr int MAIN_W = NH * HD, MEM_W = NHM * HD, INNER = MAIN_W + MEM_W;
constexpr int FOX_IN = 3 * MAIN_W + NH + MEM_W + INNER;
constexpr int RET_IN = 2 * NH * 64 + MAIN_W + MEM_W + INNER;
constexpr int PITCH = 7168;
constexpr int NPROJ0 = 7168, NPROJ1 = 5632;
constexpr int L0_Q = 0, L0_K = 1536, L0_V = 3072, L0_QM = 4608, L0_Z = 5120;
constexpr int L1_Q = 0, L1_K = 768, L1_V = 1536, L1_QM = 3072, L1_Z = 3584, L1_H = 5632;
constexpr float EPS = 1e-6f;
constexpr float SQRT_HD = 11.313708498984761f;

constexpr size_t MiB = 1u << 20;
constexpr size_t WS_WIN = 0, WS_WKV = 14 * MiB, WS_WOUT = 16 * MiB, WS_PROJ = 20 * MiB, WS_MEMN = 244 * MiB, WS_KVM = 248 * MiB,
                 WS_CS = 252 * MiB, WS_ROT = 252 * MiB + 768 * 1024, WS_CTL = 254 * MiB, WS_END = 254 * MiB + 4096;

typedef unsigned short bf16_t;
typedef short bf16x8 __attribute__((ext_vector_type(8)));
typedef short s16x4 __attribute__((ext_vector_type(4)));
typedef float f32x4 __attribute__((ext_vector_type(4)));
typedef float f32x16 __attribute__((ext_vector_type(16)));
typedef unsigned u32x4 __attribute__((ext_vector_type(4)));
typedef unsigned u32x2 __attribute__((ext_vector_type(2)));

__device__ __forceinline__ unsigned cvtpk(float lo, float hi) { unsigned r; asm volatile("v_cvt_pk_bf16_f32 %0, %1, %2" : "=v"(r) : "v"(lo), "v"(hi)); return r; }
__device__ __forceinline__ float bf2f(unsigned short b) { return __uint_as_float(((unsigned)b) << 16); }
__device__ __forceinline__ float silu_f(float z) { return z * __builtin_amdgcn_rcpf(1.0f + __builtin_amdgcn_exp2f(-1.4426950408889634f * z)); }

namespace pg8 {
#define PG8_LAS __attribute__((address_space(3)))
constexpr int BM = 256, BK = 64, HALF = 128, HTB = HALF * BK * 2, STAGE_BYTES = 8 * HTB, NXCD = 8, WGM = 8;
__host__ __device__ __forceinline__ int lds_byte(int r, int c) { const int st = (r >> 4) * 2 + (c >> 5), rr = r & 15, cc = c & 31, ob = rr * 64 + cc * 2; return st * 1024 + (ob ^ (((ob >> 9) & 1) << 5)); }
__host__ __device__ __forceinline__ void stage_rc(int b, int& R, int& C) { const int st = b / 1024, sb = b % 1024, swz = sb ^ (((sb >> 9) & 1) << 5); R = (st >> 1) * 16 + swz / 64; C = (st & 1) * 32 + (swz % 64) / 2; }
__host__ __device__ __forceinline__ int perm32(int rho) { const int n = rho >> 4, i = rho & 15; return 8 * (i >> 2) + 4 * n + (i & 3); }
struct Unit { int pm, pn; };
struct Gemm { const bf16_t* A; const bf16_t* Bt; int M, N, K, lda, ldb, kj_tile, kj_bytes; };
struct StaticOrder {
    int nM, nN, nwg, G, c;
    __host__ __device__ void init(int M, int N, int G_, int c_) { nM = M / BM; nN = N / BM; nwg = nM * nN; G = G_; c = c_; }
    __host__ __device__ bool next(int i, Unit& u) const {
        const long L = (long)i * G + c; if (L >= nwg) return false;
        int wgid = (int)L; { const int q = nwg / NXCD, r = nwg % NXCD, xcd = wgid % NXCD, off = wgid / NXCD; wgid = (xcd < r ? xcd * (q + 1) : r * (q + 1) + (xcd - r) * q) + off; }
        const int nig = WGM * nN, gid = wgid / nig, fm = gid * WGM, gsz = (nM - fm) < WGM ? (nM - fm) : WGM;
        u.pm = fm + ((wgid % nig) % gsz); u.pn = (wgid % nig) / gsz; return true;
    }
};
struct EpiBf16 {
    bf16_t* O; int ldc;
    __device__ __forceinline__ void operator()(const f32x4 (&acc)[2][2][4][2], const Unit& u, int wr, int wc, int fr, int fq) const {
        const int row0 = u.pm * BM + wr * 64 + fr; const int col0 = u.pn * BM + wc * 32 + 8 * fq;
#pragma unroll
        for (int ai = 0; ai < 2; ++ai)
#pragma unroll
            for (int m = 0; m < 4; ++m) { bf16_t* rowp = O + (size_t)(row0 + ai * HALF + m * 16) * ldc + col0;
#pragma unroll
                for (int bj = 0; bj < 2; ++bj) { const f32x4 v0 = acc[ai][bj][m][0], v1 = acc[ai][bj][m][1];
                    u32x4 w; w.x = cvtpk(v0[0], v0[1]); w.y = cvtpk(v0[2], v0[3]); w.z = cvtpk(v1[0], v1[1]); w.w = cvtpk(v1[2], v1[3]);
                    *(u32x4*)(rowp + bj * HALF) = w; } }
    }
};
struct EpiRot {
    bf16_t* O; int ldc; const float* rot;
    __device__ __forceinline__ void operator()(const f32x4 (&acc)[2][2][4][2], const Unit& u, int wr, int wc, int fr, int fq) const {
        const int row0 = u.pm * BM + wr * 64 + fr; const int col0 = u.pn * BM + wc * 32 + 8 * fq;
        const bool isrot = u.pn < 6; const float sc = (u.pn >= 3 && u.pn < 6) ? 0.125f : 1.0f;
        const int i0 = (wc & 1) * 16 + 4 * fq;
#pragma unroll
        for (int ai = 0; ai < 2; ++ai)
#pragma unroll
            for (int m = 0; m < 4; ++m) { const int row = row0 + ai * HALF + m * 16; bf16_t* rowp = O + (size_t)row * ldc + col0;
                f32x4 cs0 = {1.f, 0.f, 1.f, 0.f}, cs1 = {1.f, 0.f, 1.f, 0.f};
                if (isrot) { const float* rp = rot + ((size_t)(row & (SEQ - 1)) * 32 + i0) * 2; cs0 = *(const f32x4*)rp; cs1 = *(const f32x4*)(rp + 4); }
#pragma unroll
                for (int bj = 0; bj < 2; ++bj) { f32x4 v0 = acc[ai][bj][m][0], v1 = acc[ai][bj][m][1];
                    if (isrot) {
                        const float a0 = v0[0] * cs0[0] - v0[1] * cs0[1], b0 = v0[0] * cs0[1] + v0[1] * cs0[0];
                        const float a1 = v0[2] * cs0[2] - v0[3] * cs0[3], b1 = v0[2] * cs0[3] + v0[3] * cs0[2];
                        const float a2 = v1[0] * cs1[0] - v1[1] * cs1[1], b2 = v1[0] * cs1[1] + v1[1] * cs1[0];
                        const float a3 = v1[2] * cs1[2] - v1[3] * cs1[3], b3 = v1[2] * cs1[3] + v1[3] * cs1[2];
                        v0 = (f32x4){a0 * sc, b0 * sc, a1 * sc, b1 * sc}; v1 = (f32x4){a2 * sc, b2 * sc, a3 * sc, b3 * sc}; }
                    u32x4 w; w.x = cvtpk(v0[0], v0[1]); w.y = cvtpk(v0[2], v0[3]); w.z = cvtpk(v1[0], v1[1]); w.w = cvtpk(v1[2], v1[3]);
                    *(u32x4*)(rowp + bj * HALF) = w; } }
    }
};
struct EpiRes {
    const float* base; float* out; int ldc;
    __device__ __forceinline__ void operator()(const f32x4 (&acc)[2][2][4][2], const Unit& u, int wr, int wc, int fr, int fq) const {
        const int row0 = u.pm * BM + wr * 64 + fr; const int col0 = u.pn * BM + wc * 32 + 8 * fq;
#pragma unroll
        for (int ai = 0; ai < 2; ++ai)
#pragma unroll
            for (int m = 0; m < 4; ++m) { const size_t off = (size_t)(row0 + ai * HALF + m * 16) * ldc + col0;
#pragma unroll
                for (int bj = 0; bj < 2; ++bj) {
                    const f32x4 b0 = *(const f32x4*)(base + off + bj * HALF), b1 = *(const f32x4*)(base + off + bj * HALF + 4);
                    *(f32x4*)(out + off + bj * HALF) = b0 + acc[ai][bj][m][0]; *(f32x4*)(out + off + bj * HALF + 4) = b1 + acc[ai][bj][m][1]; } }
    }
};

template <class Epi, class Sched>
__device__ __forceinline__ void gemm_phase(PG8_LAS unsigned char* lds, const Gemm g, const Sched& S, const Epi& E) {
    const int tid = threadIdx.x, wid = __builtin_amdgcn_readfirstlane(tid >> 6), lane = tid & 63, wr = wid >> 2, wc = wid & 3, fr = lane & 15, fq = lane >> 4;
    const int K = g.K, nt = K / BK;
    unsigned voffA[2], voffB[2];
#pragma unroll
    for (int i = 0; i < 2; ++i) { int R, C; stage_rc(tid * 16 + i * 8192, R, C); const int Rb = (R & ~31) + perm32(R & 31);
        voffA[i] = (unsigned)(R * g.lda + C) * 2u; voffB[i] = (unsigned)(Rb * g.ldb + C) * 2u; }
    const size_t kstep = (size_t)(BK * 2);
    const size_t hstepA = (size_t)HALF * g.lda * 2, hstepB = (size_t)HALF * g.ldb * 2;
    const size_t tstepA = 2 * hstepA, tstepB = 2 * hstepB;
    const unsigned ldsw = (unsigned)wid * 1024u;
    const int aoff = lds_byte(wr * 64 + fr, fq * 8), boff = lds_byte(wc * 32 + fr, fq * 8);
    const int kjt = g.kj_tile; const size_t kjb = (size_t)(long)g.kj_bytes;
#define PG8_AK(t) ((size_t)(t) * kstep + (((t) >= kjt) ? kjb : (size_t)0))
#define PG8_SA(b, h) (((b) * 2 + (h)) * HTB)
#define PG8_SB(b, h) ((4 + (b) * 2 + (h)) * HTB)
#define PG8_STAGE(bufoff, gbase, voff) do { _Pragma("unroll") for (int _i = 0; _i < 2; ++_i) \
        __builtin_amdgcn_global_load_lds((const unsigned*)((const char*)(gbase) + (voff)[_i]), (PG8_LAS unsigned*)(lds + (bufoff) + ldsw + _i * 8192), 16, 0, 0); } while (0)
#define PG8_LDA(dst, b, h) do { _Pragma("unroll") for (int m = 0; m < 4; ++m) _Pragma("unroll") for (int k = 0; k < 2; ++k) dst[m][k] = *(const PG8_LAS bf16x8*)(lds + PG8_SA(b, h) + aoff + m * 2048 + k * 1024); } while (0)
#define PG8_LDB(dst, b, h) do { _Pragma("unroll") for (int n = 0; n < 2; ++n) _Pragma("unroll") for (int k = 0; k < 2; ++k) dst[n][k] = *(const PG8_LAS bf16x8*)(lds + PG8_SB(b, h) + boff + n * 2048 + k * 1024); } while (0)
#define PG8_MMA(ai, bj, At, Bt) do { __builtin_amdgcn_s_setprio(1); _Pragma("unroll") for (int m = 0; m < 4; ++m) _Pragma("unroll") for (int n = 0; n < 2; ++n) _Pragma("unroll") for (int k = 0; k < 2; ++k) \
        acc[ai][bj][m][n] = __builtin_amdgcn_mfma_f32_16x16x32_bf16(Bt[n][k], At[m][k], acc[ai][bj][m][n], 0, 0, 0); __builtin_amdgcn_s_setprio(0); } while (0)
#define PG8_WAIT_V(n) asm volatile("s_waitcnt vmcnt(" #n ")" ::: "memory")
#define PG8_WAIT_L(n) asm volatile("s_waitcnt lgkmcnt(" #n ")" ::: "memory")
#define PG8_BAR __builtin_amdgcn_s_barrier()
#define PG8_SCHED __builtin_amdgcn_sched_barrier(0)
    Unit cur, nxt; int ui = 0;
    if (!S.next(0, cur)) return;
    f32x4 acc[2][2][4][2];
#pragma unroll
    for (int a = 0; a < 2; ++a)
#pragma unroll
        for (int b = 0; b < 2; ++b)
#pragma unroll
            for (int m = 0; m < 4; ++m)
#pragma unroll
                for (int n = 0; n < 2; ++n) acc[a][b][m][n] = (f32x4){0.f, 0.f, 0.f, 0.f};
    bf16x8 At[4][2], B0[2][2], B1[2][2];
    const char* cA = (const char*)g.A + (size_t)cur.pm * tstepA; const char* cB = (const char*)g.Bt + (size_t)cur.pn * tstepB;
    PG8_STAGE(PG8_SB(0, 0), cB, voffB); PG8_STAGE(PG8_SB(0, 1), cB + hstepB, voffB); PG8_STAGE(PG8_SA(0, 0), cA, voffA); PG8_STAGE(PG8_SA(0, 1), cA + hstepA, voffA);
    if (wr == 1) PG8_BAR;
    PG8_WAIT_V(2); PG8_BAR;
    PG8_STAGE(PG8_SB(1, 0), cB + kstep, voffB); PG8_STAGE(PG8_SA(1, 0), cA + kstep, voffA); PG8_STAGE(PG8_SB(1, 1), cB + hstepB + kstep, voffB);
    PG8_WAIT_V(6); PG8_BAR;
    for (;;) {
        const bool has_next = S.next(ui + 1, nxt);
        const char* nA = has_next ? (const char*)g.A + (size_t)nxt.pm * tstepA : cA; const char* nB = has_next ? (const char*)g.Bt + (size_t)nxt.pn * tstepB : cB;
        for (int t = 0; t < nt; t += 2) {
            const bool last = (t == nt - 2);
            const char* a1 = cA + PG8_AK(t + 1);
            const char* a2 = last ? nA : cA + PG8_AK(t + 2); const char* b2 = last ? nB : cB + (size_t)(t + 2) * kstep;
            const char* a3 = a2 + kstep; const char* b3 = b2 + kstep;
            PG8_LDB(B0, 0, 0); PG8_LDB(B1, 0, 1); PG8_SCHED; PG8_LDA(At, 0, 0); PG8_STAGE(PG8_SA(1, 1), a1 + hstepA, voffA);
            PG8_WAIT_V(8); PG8_WAIT_L(0); PG8_BAR; PG8_MMA(0, 0, At, B0); PG8_MMA(0, 1, At, B1); PG8_BAR; PG8_SCHED;
            PG8_LDA(At, 0, 1); PG8_STAGE(PG8_SB(0, 0), b2, voffB); PG8_STAGE(PG8_SB(0, 1), b2 + hstepB, voffB); PG8_STAGE(PG8_SA(0, 0), a2, voffA);
            PG8_WAIT_V(8); PG8_WAIT_L(0); PG8_BAR; PG8_MMA(1, 0, At, B0); PG8_MMA(1, 1, At, B1); PG8_BAR; PG8_SCHED;
            PG8_LDB(B0, 1, 0); PG8_LDB(B1, 1, 1); PG8_SCHED; PG8_LDA(At, 1, 0); PG8_STAGE(PG8_SA(0, 1), a2 + hstepA, voffA);
            PG8_WAIT_V(8); PG8_WAIT_L(0); PG8_BAR; PG8_MMA(0, 0, At, B0); PG8_MMA(0, 1, At, B1); PG8_BAR; PG8_SCHED;
            PG8_LDA(At, 1, 1); PG8_STAGE(PG8_SB(1, 0), b3, voffB); PG8_STAGE(PG8_SB(1, 1), b3 + hstepB, voffB); PG8_STAGE(PG8_SA(1, 0), a3, voffA);
            PG8_WAIT_V(8); PG8_WAIT_L(0); PG8_BAR; PG8_MMA(1, 0, At, B0); PG8_MMA(1, 1, At, B1); PG8_BAR; PG8_SCHED;
        }
        if (wr == 0) PG8_BAR;
        E(acc, cur, wr, wc, fr, fq);
        if (!has_next) break;
#pragma unroll
        for (int a = 0; a < 2; ++a)
#pragma unroll
            for (int b = 0; b < 2; ++b)
#pragma unroll
                for (int m = 0; m < 4; ++m)
#pragma unroll
                    for (int n = 0; n < 2; ++n) acc[a][b][m][n] = (f32x4){0.f, 0.f, 0.f, 0.f};
        cur = nxt; cA = nA; cB = nB; ++ui;
        if (wr == 1) PG8_BAR;
    }
    PG8_WAIT_V(0);
    PG8_BAR;
#undef PG8_AK
#undef PG8_SA
#undef PG8_SB
#undef PG8_STAGE
#undef PG8_LDA
#undef PG8_LDB
#undef PG8_MMA
#undef PG8_WAIT_V
#undef PG8_WAIT_L
#undef PG8_BAR
#undef PG8_SCHED
}
}

namespace att {
constexpr int NW = 8, QBLK = 32, KVBLK = 64, QB = NW * QBLK, D = 128;
constexpr int SHM_V = KVBLK * D * 2, SHM_K = KVBLK * D * 2;
constexpr int OFF_WS = 2 * SHM_V + 2 * SHM_K, OFF_CS = OFF_WS + NW * 64 * 4, LDS_BYTES = OFF_CS + 2 * SEQ * 4;
constexpr float SCALE = 0.08838834764831845f;
constexpr float THR = 8.f;
constexpr int LDQ = PITCH;
#define KSWZ(row, colB) ((row) * 256 + ((colB) ^ (((row) & 7) << 4)))
#define SBAR() __builtin_amdgcn_sched_barrier(0)
__device__ __forceinline__ int v_st(int k, int c) { const int kk = (k & ~0xC) | ((k & 4) << 1) | ((k & 8) >> 1); return ((kk >> 3) * 4 + (c >> 5)) * 512 + ((kk & 7) * 32 + (c & 31)) * 2; }
__device__ __forceinline__ int v_rd_base(int lane) { return ((lane & 3) << 3) | (((lane >> 2) & 3) << 6) | (((lane >> 4) & 1) << 5) | (((lane >> 5) & 1) << 8); }
constexpr int v_rd_off(int d0, int ks, int half) { return d0 * 512 + ks * 4096 + half * 2048; }
__device__ __forceinline__ int crow(int r, int hi) { return (r & 3) + 8 * (r >> 2) + 4 * hi; }
__device__ __forceinline__ bf16x8 load8(const bf16_t* p) { return *reinterpret_cast<const bf16x8*>(p); }
__device__ __forceinline__ void mask_tile(f32x16& p0, f32x16& p1, int dq) {
    const float NEG = -__builtin_inff();
#pragma unroll
    for (int r = 0; r < 16; ++r) {
        const int c = (r & 3) + 8 * (r >> 2);
        if (dq - c < 0) p0[r] = NEG;
        if (dq - c - 32 < 0) p1[r] = NEG;
    }
}
__device__ __forceinline__ void bias_tile(f32x16& p0, f32x16& p1, const float* cb, float cq) {
#pragma unroll
    for (int j = 0; j < 4; ++j) { const f32x4 c0 = *(const f32x4*)(cb + 8 * j), c1 = *(const f32x4*)(cb + 8 * j + 32);
#pragma unroll
        for (int i = 0; i < 4; ++i) { p0[4 * j + i] = (p0[4 * j + i] + cq) - c0[i]; p1[4 * j + i] = (p1[4 * j + i] + cq) - c1[i]; }
        if (j & 1) SBAR(); }
}
__device__ __forceinline__ void decay_tile(f32x16& p0, f32x16& p1, int dq, float lg2, float g1, float g2, float g3, float g32, bool needmask) {
    const float e0 = lg2 * (float)dq;
#pragma unroll
    for (int j = 0; j < 4; ++j) { const float f0 = __builtin_amdgcn_exp2f(fmaf(-lg2, (float)(8 * j), e0)), f1 = f0 * g1, f2 = f0 * g2, f3 = f0 * g3;
        p0[4 * j + 0] *= f0; p0[4 * j + 1] *= f1; p0[4 * j + 2] *= f2; p0[4 * j + 3] *= f3;
        p1[4 * j + 0] *= f0 * g32; p1[4 * j + 1] *= f1 * g32; p1[4 * j + 2] *= f2 * g32; p1[4 * j + 3] *= f3 * g32; }
    if (needmask) {
#pragma unroll
        for (int r = 0; r < 16; ++r) { const int c = (r & 3) + 8 * (r >> 2); if (dq - c < 0) p0[r] = 0.f; if (dq - c - 32 < 0) p1[r] = 0.f; }
    }
}
__device__ __forceinline__ void partialSM(f32x16& p0, f32x16& p1, float& m_reg, float& mn, float& alpha) {
    float pmax = p0[0];
#pragma unroll
    for (int r = 1; r < 16; ++r) pmax = fmaxf(pmax, p0[r]);
#pragma unroll
    for (int r = 0; r < 16; ++r) pmax = fmaxf(pmax, p1[r]);
    { auto rr = __builtin_amdgcn_permlane32_swap(__float_as_uint(pmax), __float_as_uint(pmax), false, false);
      pmax = fmaxf(__uint_as_float(rr[0]), __uint_as_float(rr[1])); }
    constexpr float C2 = 1.4426950408889634f * SCALE;
    if (__builtin_expect(__all((pmax - m_reg) * SCALE <= THR), 1)) { mn = m_reg; alpha = 1.f; }
    else { mn = fmaxf(m_reg, pmax); alpha = __builtin_amdgcn_exp2f((m_reg - mn) * C2); m_reg = mn; }
    const float mnL = -mn * C2;
#pragma unroll
    for (int r = 0; r < 16; ++r) p0[r] = fmaf(p0[r], C2, mnL);
#pragma unroll
    for (int r = 0; r < 16; ++r) p1[r] = fmaf(p1[r], C2, mnL);
#pragma unroll
    for (int r = 0; r < 16; ++r) p0[r] = __builtin_amdgcn_exp2f(p0[r]);
}
#define PK4(P, B_, OUT) do { unsigned a0 = cvtpk(P[B_+0], P[B_+1]), a1 = cvtpk(P[B_+2], P[B_+3]);                          \
        unsigned b0 = cvtpk(P[B_+4], P[B_+5]), b1 = cvtpk(P[B_+6], P[B_+7]);                                             \
        auto r0 = __builtin_amdgcn_permlane32_swap(a0, b0, false, false); auto r1 = __builtin_amdgcn_permlane32_swap(a1, b1, false, false); \
        u32x4 w = {r0[0], r1[0], r0[1], r1[1]}; OUT = *reinterpret_cast<bf16x8*>(&w); } while (0)
template <bool SOFTMAX>
__device__ __forceinline__ void finishSM(f32x16& p0, f32x16& p1, float alpha, float& l_reg, bf16x8& pa0, bf16x8& pa1, bf16x8& pa2, bf16x8& pa3) {
    if (SOFTMAX) {
#pragma unroll
        for (int r = 0; r < 16; ++r) p1[r] = __builtin_amdgcn_exp2f(p1[r]);
        float ps = 0;
#pragma unroll
        for (int r = 0; r < 16; ++r) ps += p0[r];
#pragma unroll
        for (int r = 0; r < 16; ++r) ps += p1[r];
        { auto rr = __builtin_amdgcn_permlane32_swap(__float_as_uint(ps), __float_as_uint(ps), false, false);
          ps = __uint_as_float(rr[0]) + __uint_as_float(rr[1]); }
        l_reg = l_reg * alpha + ps;
    }
    PK4(p0, 0, pa0); PK4(p0, 8, pa1); PK4(p1, 0, pa2); PK4(p1, 8, pa3);
}
#undef PK4
template <int KB, int NQF>
__device__ __forceinline__ void qkt(f32x16& p0, f32x16& p1, const char* K_lds, int r32, int hi, const bf16x8* qr) {
    p0 = f32x16{}; p1 = f32x16{};
    const char* kb[4];
#pragma unroll
    for (int dd = 0; dd < 4; ++dd) kb[dd] = K_lds + KB * SHM_K + KSWZ(r32, (dd * 16 + hi * 8) * 2);
#pragma unroll
    for (int d0 = 0; d0 < NQF; ++d0) { const char* a = kb[d0 & 3] + (d0 >> 2) * 128;
        bf16x8 b0 = *reinterpret_cast<const bf16x8*>(a);
        bf16x8 b1 = *reinterpret_cast<const bf16x8*>(a + 32 * 256);
        p0 = __builtin_amdgcn_mfma_f32_32x32x16_bf16(b0, qr[d0], p0, 0, 0, 0);
        p1 = __builtin_amdgcn_mfma_f32_32x32x16_bf16(b1, qr[d0], p1, 0, 0, 0); }
}
template <int VB>
__device__ __forceinline__ void pv_tile(f32x16* o, int vb0, bf16x8 pa0, bf16x8 pa1, bf16x8 pa2, bf16x8 pa3) {
#define TRRD(dst, off) asm volatile("ds_read_b64_tr_b16 %0, %1 offset:%2" : "=&v"(dst) : "v"(vb0), "i"(off) : "memory")
#define PV_D0(d0) do { s16x4 l0, l1, l2, l3, h0, h1, h2, h3; constexpr int b_ = VB * SHM_V + v_rd_off(d0, 0, 0); \
        TRRD(l0, b_); TRRD(h0, b_ + 2048); TRRD(l1, b_ + 4096); TRRD(h1, b_ + 6144); TRRD(l2, b_ + 8192); TRRD(h2, b_ + 10240); TRRD(l3, b_ + 12288); TRRD(h3, b_ + 14336); \
        asm volatile("s_waitcnt lgkmcnt(0)" ::: "memory"); SBAR();   \
        o[d0] = __builtin_amdgcn_mfma_f32_32x32x16_bf16(pa0, (bf16x8){l0[0], l0[1], l0[2], l0[3], h0[0], h0[1], h0[2], h0[3]}, o[d0], 0, 0, 0);   \
        o[d0] = __builtin_amdgcn_mfma_f32_32x32x16_bf16(pa1, (bf16x8){l1[0], l1[1], l1[2], l1[3], h1[0], h1[1], h1[2], h1[3]}, o[d0], 0, 0, 0);   \
        o[d0] = __builtin_amdgcn_mfma_f32_32x32x16_bf16(pa2, (bf16x8){l2[0], l2[1], l2[2], l2[3], h2[0], h2[1], h2[2], h2[3]}, o[d0], 0, 0, 0);   \
        o[d0] = __builtin_amdgcn_mfma_f32_32x32x16_bf16(pa3, (bf16x8){l3[0], l3[1], l3[2], l3[3], h3[0], h3[1], h3[2], h3[3]}, o[d0], 0, 0, 0); } while (0)
    PV_D0(0); PV_D0(1); PV_D0(2); PV_D0(3);
#undef PV_D0
#undef TRRD
}

struct BlockRef { const bf16_t* Q; const bf16_t* K; const bf16_t* V; bf16_t* O; const bf16_t* Z; const float* cs; int P0, skv; float lg2; };
struct Seam { bf16x8 qr[8]; bf16x8 st_v0, st_v1, st_k0, st_k1; };
#define GLD8(base, off) (*(const bf16x8*)((const char*)(base) + (off)))
#define VMW() asm volatile("s_waitcnt vmcnt(0)" ::: "memory")
#define VMWN(n) asm volatile("s_waitcnt vmcnt(%0)" :: "i"(n) : "memory")
#define SLOAD_H(Kp, Vp, k0) do { S.st_v0 = GLD8((Vp) + (size_t)(k0) * LDKV, kvoff); S.st_v1 = GLD8((Vp) + (size_t)((k0) + 32) * LDKV, kvoff);              \
                         if (sc < DQ) { S.st_k0 = GLD8((Kp) + (size_t)(k0) * LDKV, kvoff); S.st_k1 = GLD8((Kp) + (size_t)((k0) + 32) * LDKV, kvoff); } } while (0)
#define SWRITE_HK(bf) do { if (sc < DQ) { *(bf16x8*)(K_lds + (bf) * SHM_K + kws) = S.st_k0; *(bf16x8*)(K_lds + (bf) * SHM_K + kws + 32 * 256) = S.st_k1; } } while (0)
#define SWRITE_HV(bf) do { *(bf16x8*)(V_lds + (bf) * SHM_V + vst0) = S.st_v0; *(bf16x8*)(V_lds + (bf) * SHM_V + vst1) = S.st_v1; } while (0)
#define SWRITE_H(bf) do { SWRITE_HV(bf); SWRITE_HK(bf); } while (0)
template <int MODE>
__device__ __forceinline__ void mix_prime(const BlockRef& cur, char* lds, Seam& S) {
    constexpr int DQ = MODE == 2 ? 64 : 128, NQF = DQ / 16, LDKV = MODE == 1 ? 1024 : PITCH;
    const int tid = threadIdx.x, wid = __builtin_amdgcn_readfirstlane(tid >> 6), lane = tid & 63, r32 = lane & 31, hi = lane >> 5;
    const int sr = tid >> 4, sc = (tid & 15) * 8, kws = KSWZ(sr, sc * 2); char* K_lds = lds + 2 * SHM_V;
    const unsigned qoff = (unsigned)(((wid * QBLK + r32) * LDQ + hi * 8) * 2), kvoff = (unsigned)((sr * LDKV + sc) * 2);
#pragma unroll
    for (int d0 = 0; d0 < NQF; ++d0) S.qr[d0] = GLD8(cur.Q + d0 * 16, qoff);
    SLOAD_H(cur.K, cur.V, 0);
    if (MODE == 0) { const f32x4 c = *(const f32x4*)(cur.cs + tid * 4); *(f32x4*)((float*)(lds + OFF_CS) + tid * 4) = c; }
    VMW(); SWRITE_HK(0);
    __syncthreads();
}
template <int MODE>
__device__ __forceinline__ void mix_block(const BlockRef& cur, const BlockRef& nxt, char* lds, Seam& S, int par) {
    constexpr int DQ = MODE == 2 ? 64 : 128, NQF = DQ / 16, LDKV = MODE == 1 ? 1024 : PITCH; constexpr bool CAUSAL = MODE != 1, SOFTMAX = MODE != 2;
    const int tid = threadIdx.x, wid = __builtin_amdgcn_readfirstlane(tid >> 6), lane = tid & 63, r32 = lane & 31, hi = lane >> 5;
    const int NT = CAUSAL ? cur.P0 / KVBLK + 4 : cur.skv / KVBLK;
    const int qlo = cur.P0 + wid * QBLK, qm = qlo + r32 - 4 * hi;
    char* V_lds = lds; char* K_lds = lds + 2 * SHM_V;
    float* ws = (float*)(lds + OFF_WS) + wid * 64; float* li_l = ws, * al_l = ws + 32;
    const float* cs_cur = (const float*)(lds + OFF_CS) + par * SEQ; float* cs_nxt = (float*)(lds + OFF_CS) + (par ^ 1) * SEQ;
    float m_reg = -1e30f, l_reg = 0; f32x16 o[4] = {};
    const int sr = tid >> 4, sc = (tid & 15) * 8, vst0 = v_st(sr, sc), vst1 = v_st(32 + sr, sc), kws = KSWZ(sr, sc * 2);
    const int vb0 = (int)(uintptr_t)V_lds + v_rd_base(lane);
    const bf16_t* Kh = cur.K; const bf16_t* Vh = cur.V;
    const unsigned qoff = (unsigned)(((wid * QBLK + r32) * LDQ + hi * 8) * 2), kvoff = (unsigned)((sr * LDKV + sc) * 2), eoff = (unsigned)(((wid * QBLK + 4 * hi) * LDQ + r32) * 2);
    float cq = 0.f; if (MODE == 0) cq = cs_cur[qlo + r32];
    const float lg2 = cur.lg2;
    float g1 = 1.f, g2 = 1.f, g3 = 1.f, g32 = 1.f;
    if (MODE == 2) { g1 = __uint_as_float(__builtin_amdgcn_readfirstlane(__float_as_uint(__builtin_amdgcn_exp2f(-lg2)))); g2 = g1 * g1; g3 = g2 * g1;
        g32 = __uint_as_float(__builtin_amdgcn_readfirstlane(__float_as_uint(__builtin_amdgcn_exp2f(-32.f * lg2)))); }
#define RESC(a) do { if (SOFTMAX) { if (__any((a) < 1.f)) { if (hi == 0) al_l[r32] = (a); asm volatile("s_waitcnt lgkmcnt(0)" ::: "memory");              \
                     for (int d_ = 0; d_ < 4; ++d_) for (int r = 0; r < 16; ++r) o[d_][r] *= al_l[crow(r, hi)]; } } } while (0)
#define KBASE(t) ((t) * KVBLK)
#define SCORE_FIX(P0_, P1_, mnX, alX, t) do { const int kb_ = KBASE(t);                                                                    \
        if (MODE == 0) { bias_tile(P0_, P1_, cs_cur + kb_ + 4 * hi, cq); }                                                      \
        if (MODE == 2) { decay_tile(P0_, P1_, qm - kb_, lg2, g1, g2, g3, g32, kb_ + KVBLK - 1 > qlo); }                            \
        else { if (CAUSAL && (kb_ + KVBLK - 1 > qlo)) mask_tile(P0_, P1_, qm - kb_); partialSM(P0_, P1_, m_reg, mnX, alX); } } while (0)
#define SEAM_K0() do { VMWN(NQF); SWRITE_HK(0); SBAR(); if (MODE == 0) { const f32x4 c_ = *(const f32x4*)(nxt.cs + tid * 4); *(f32x4*)(cs_nxt + tid * 4) = c_; } SBAR(); } while (0)
    f32x16 pA0, pA1, pB0, pB1; float mnA = 0, mnB = 0, alA = 1.f, alB = 1.f; bf16x8 pa0, pa1, pa2, pa3;
    SWRITE_HV(0); SBAR();
    if (NT > 1) { SLOAD_H(Kh, Vh, KBASE(1)); }
    SBAR(); qkt<0, NQF>(pA0, pA1, K_lds, r32, hi, S.qr);
    SCORE_FIX(pA0, pA1, mnA, alA, 0);
    if (NT > 1) { VMW(); SWRITE_H(1); }
    __syncthreads();
#define HALF_STEP(PX0, PX1, mnX, alX, PY0, PY1, alY, t, KB, VB, SB) do {                                                      \
        SBAR(); qkt<KB, NQF>(PX0, PX1, K_lds, r32, hi, S.qr);                                                                 \
        finishSM<SOFTMAX>(PY0, PY1, alY, l_reg, pa0, pa1, pa2, pa3); SBAR();                                                  \
        if ((t) + 1 < NT) { SLOAD_H(Kh, Vh, KBASE((t) + 1)); SBAR(); }                                                  \
        pv_tile<VB>(o, vb0, pa0, pa1, pa2, pa3); SCORE_FIX(PX0, PX1, mnX, alX, (t));                                          \
        __syncthreads();                                                                                                      \
        if ((t) + 1 < NT) { VMW(); SWRITE_H(SB); }                                                                            \
        RESC(alX); __syncthreads(); } while (0)
    for (int t = 1; t + 1 < NT; t += 2) {
        HALF_STEP(pB0, pB1, mnB, alB, pA0, pA1, alA, t, 1, 0, 0);
        HALF_STEP(pA0, pA1, mnA, alA, pB0, pB1, alB, t + 1, 0, 1, 1);
    }
    const bool even = (NT & 1) == 0;
    if (even) { SBAR(); qkt<1, NQF>(pB0, pB1, K_lds, r32, hi, S.qr); SBAR(); }
    SLOAD_H(nxt.K, nxt.V, 0);
    SBAR();
#pragma unroll
    for (int d0 = 0; d0 < NQF; ++d0) S.qr[d0] = GLD8(nxt.Q + d0 * 16, qoff);
    SBAR();
    finishSM<SOFTMAX>(pA0, pA1, alA, l_reg, pa0, pa1, pa2, pa3); SBAR();
    pv_tile<0>(o, vb0, pa0, pa1, pa2, pa3);
    if (even) { SCORE_FIX(pB0, pB1, mnB, alB, NT - 1); __syncthreads(); RESC(alB);
        finishSM<SOFTMAX>(pB0, pB1, alB, l_reg, pa0, pa1, pa2, pa3); SBAR(); pv_tile<1>(o, vb0, pa0, pa1, pa2, pa3); }
    SBAR(); SEAM_K0();
    float rli[16];
    if (SOFTMAX) {
        if (hi == 0) li_l[r32] = l_reg; asm volatile("s_waitcnt lgkmcnt(0)" ::: "memory");
#pragma unroll
        for (int r = 0; r < 16; ++r) rli[r] = __builtin_amdgcn_rcpf(li_l[crow(r, hi)]);
    } else {
#pragma unroll
        for (int r = 0; r < 16; ++r) { float ss = o[0][r] * o[0][r] + o[1][r] * o[1][r] + o[2][r] * o[2][r] + o[3][r] * o[3][r];
            ss += __shfl_xor(ss, 1); ss += __shfl_xor(ss, 2); ss += __shfl_xor(ss, 4); ss += __shfl_xor(ss, 8); ss += __shfl_xor(ss, 16);
            rli[r] = __builtin_amdgcn_rsqf(ss * (1.0f / 128.0f) + EPS); }
    }
#pragma unroll
    for (int r = 0; r < 16; ++r) { const int orc = (r & 3) + 8 * (r >> 2);
#pragma unroll
        for (int d0 = 0; d0 < 4; ++d0) { const float v = o[d0][r] * rli[r];
            const float vn = __shfl_xor(v, 1);
            if ((r32 & 1) == 0) { const unsigned zz = *(const unsigned*)((const char*)(cur.Z + (size_t)orc * LDQ + d0 * 32) + eoff);
                const float g0 = silu_f(__uint_as_float(zz << 16)), g1 = silu_f(__uint_as_float(zz & 0xffff0000u));
                *(unsigned*)((char*)(cur.O + (size_t)orc * LDQ + d0 * 32) + eoff) = cvtpk(v * g0, vn * g1); } } }
    __syncthreads();
#undef RESC
#undef KBASE
#undef SCORE_FIX
#undef SEAM_K0
#undef HALF_STEP
}
#undef GLD8
#undef VMW
#undef VMWN
#undef SLOAD_H
#undef SWRITE_HK
#undef SWRITE_HV
#undef SWRITE_H
}

constexpr int NTHR = 512;
constexpr int LDS_BYTES = 135168;
struct Args { const float* in[10]; float* out; unsigned char* ws; int ph_lo, ph_hi; };

__device__ __forceinline__ float wave_sum(float v) {
    v += __shfl_xor(v, 1); v += __shfl_xor(v, 2); v += __shfl_xor(v, 4); v += __shfl_xor(v, 8); v += __shfl_xor(v, 16); v += __shfl_xor(v, 32); return v;
}
__device__ __forceinline__ void rms_row(const float* xr, const float* g, bf16_t* outr, int lane, f32x4 (&y)[4]) {
    float ss = 0.f;
#pragma unroll
    for (int i = 0; i < 4; ++i) { y[i] = *(const f32x4*)(xr + 256 * i + 4 * lane); ss += y[i][0] * y[i][0] + y[i][1] * y[i][1] + y[i][2] * y[i][2] + y[i][3] * y[i][3]; }
    ss = wave_sum(ss);
    const float rs = 1.0f / sqrtf(ss * (1.0f / 1024.0f) + EPS);
#pragma unroll
    for (int i = 0; i < 4; ++i) { const f32x4 gg = *(const f32x4*)(g + 256 * i + 4 * lane); y[i] = y[i] * rs * gg;
        u32x2 w; w.x = cvtpk(y[i][0], y[i][1]); w.y = cvtpk(y[i][2], y[i][3]); *(u32x2*)(outr + 256 * i + 4 * lane) = w; }
}
template <class Map>
__device__ __forceinline__ void transpose_tiles(const float* W, int ldw, int K, int N, bf16_t* Wt, float* tile, int& tcount, int G, int c, const Map& srcmap) {
    const int tid = threadIdx.x; const int ntk = K / 64, ntn = N / 64;
    for (int t = 0; t < ntk * ntn; ++t, ++tcount) {
        if (tcount % G != c) continue;
        const int k0 = (t % ntk) * 64, n0 = (t / ntk) * 64;
        __syncthreads();
        { const int n = tid & 63, kk = tid >> 6; const int sn = srcmap(n0 + n);
#pragma unroll
          for (int i = 0; i < 8; ++i) tile[(kk + 8 * i) * 65 + n] = W[(size_t)(k0 + kk + 8 * i) * ldw + sn]; }
        __syncthreads();
        { const int k = (tid & 31) * 2, nn = tid >> 5;
#pragma unroll
          for (int i = 0; i < 4; ++i) { const int n = nn + 16 * i; *(unsigned*)(Wt + (size_t)(n0 + n) * K + k0 + k) = cvtpk(tile[k * 65 + n], tile[(k + 1) * 65 + n]); } }
    }
}
struct MapL0 { __device__ int operator()(int n) const { return n < 4608 ? n : n + 12; } };
struct MapL1 { __device__ int operator()(int n) const { if (n >= 1536) return n; const int p = n & 63; return (n & ~63) + (p & 1) * 32 + (p >> 1); } };
struct MapId { __device__ int operator()(int n) const { return n; } };

template <int MODE>
__device__ __forceinline__ bool get_block(int layer, int G, int c, int k, unsigned char* ws, att::BlockRef& r) {
    bf16_t* proj = (bf16_t*)(ws + WS_PROJ);
    if (MODE == 1) {
        const int L = c + k * G; if (L >= NB * NHM * 8) return false;
        const int qb = L & 7, hm = (L >> 3) & 3, b = L >> 5;
        const int qcol = (layer == 0 ? L0_QM : L1_QM) + hm * 128, zcol = (layer == 0 ? L0_Z : L1_Z) + MAIN_W + hm * 128;
        const size_t row0 = (size_t)b * SEQ + qb * 256;
        const bf16_t* kvm = (const bf16_t*)(ws + WS_KVM) + (size_t)b * NMEM * 1024;
        r.Q = proj + row0 * PITCH + qcol; r.O = proj + row0 * PITCH + qcol; r.Z = proj + row0 * PITCH + zcol;
        r.K = kvm + hm * 128; r.V = kvm + 512 + hm * 128; r.cs = nullptr; r.P0 = 0; r.skv = NMEM; r.lg2 = 0.f;
        return true;
    } else {
        const int item = c + (k >> 1) * G; if (item >= NB * NH * 4) return false;
        const int bh = item >> 2, x = item & 3, qb = (k & 1) ? 7 - x : x, b = bh / NH, h = bh % NH;
        const size_t rowb = (size_t)b * SEQ, row0 = rowb + qb * 256;
        if (MODE == 0) {
            r.Q = proj + row0 * PITCH + L0_Q + h * 128; r.O = proj + row0 * PITCH + L0_Q + h * 128; r.Z = proj + row0 * PITCH + L0_Z + h * 128;
            r.K = proj + rowb * PITCH + L0_K + h * 128; r.V = proj + rowb * PITCH + L0_V + h * 128;
            r.cs = (const float*)(ws + WS_CS) + (size_t)bh * SEQ; r.lg2 = 0.f;
        } else {
            r.Q = proj + row0 * PITCH + L1_Q + h * 64; r.O = proj + row0 * PITCH + L1_H + h * 128; r.Z = proj + row0 * PITCH + L1_Z + h * 128;
            r.K = proj + rowb * PITCH + L1_K + h * 64; r.V = proj + rowb * PITCH + L1_V + h * 128;
            r.cs = nullptr; r.lg2 = __uint_as_float(__builtin_amdgcn_readfirstlane(__float_as_uint(log1pf(-exp2f(-5.0f - (float)h)) * 1.4426950408889634f)));
        }
        r.P0 = qb * 256; r.skv = SEQ;
        return true;
    }
}
template <int MODE>
__device__ __forceinline__ void run_stream(int layer, int G, int c, unsigned char* ws, char* lds) {
    att::BlockRef cur, nxt; int k = 0;
    if (!get_block<MODE>(layer, G, c, 0, ws, cur)) return;
    att::Seam S; int par = 0;
    att::mix_prime<MODE>(cur, lds, S);
    for (;;) {
        const bool has = get_block<MODE>(layer, G, c, k + 1, ws, nxt);
        if (!has) nxt = cur;
        att::mix_block<MODE>(cur, nxt, lds, S, par);
        if (!has) break;
        cur = nxt; ++k; par ^= 1;
    }
}

__global__ void __launch_bounds__(NTHR, 2) mk_fwd(Args args) {
    extern __shared__ __attribute__((aligned(16))) unsigned char lds[];
    const int tid = threadIdx.x, lane = tid & 63, wid = __builtin_amdgcn_readfirstlane(tid >> 6);
    const int G = gridDim.x, c = blockIdx.x;
    unsigned char* ws = args.ws;
    const float* x = args.in[0]; const float* mem = args.in[1]; const float* norm_g = args.in[2]; const float* fox_w_in = args.in[3]; const float* fox_b_f = args.in[4];
    const float* ret_w_in = args.in[5]; const float* mem_norm_g = args.in[6]; const float* w_mem_kv = args.in[7]; const float* w_out = args.in[8]; const float* final_g = args.in[9];
    float* out = args.out;
    bf16_t* Wt_in = (bf16_t*)(ws + WS_WIN); bf16_t* Wt_kv = (bf16_t*)(ws + WS_WKV); bf16_t* Wt_out = (bf16_t*)(ws + WS_WOUT);
    bf16_t* proj = (bf16_t*)(ws + WS_PROJ); bf16_t* memn = (bf16_t*)(ws + WS_MEMN); bf16_t* kvm = (bf16_t*)(ws + WS_KVM);
    float* cs = (float*)(ws + WS_CS); float* rot = (float*)(ws + WS_ROT);
    bf16_t* h0 = (bf16_t*)out;
    const int lo = args.ph_lo, hi_ = args.ph_hi;
#ifndef PH_MASK
#define PH_MASK 0x1ff
#endif
#define IN(k) (((PH_MASK >> (k)) & 1) && lo <= (k) && (k) < hi_)
    unsigned* barctr = (unsigned*)(ws + WS_CTL);
#define SEAM(k) do { if (IN(k) && IN((k) + 1)) { if ((k) == 0) { cg::this_grid().sync(); } else {                                     \
        __syncthreads();                                                                                                                \
        if (tid == 0) { __builtin_amdgcn_fence(__ATOMIC_RELEASE, "agent"); __hip_atomic_fetch_add(barctr, 1u, __ATOMIC_RELAXED, __HIP_MEMORY_SCOPE_AGENT);   \
            while (__hip_atomic_load(barctr, __ATOMIC_RELAXED, __HIP_MEMORY_SCOPE_AGENT) < (unsigned)(k) * (unsigned)G) __builtin_amdgcn_s_sleep(2); }       \
        __syncthreads(); __builtin_amdgcn_fence(__ATOMIC_ACQUIRE, "agent"); } } } while (0)

    if (IN(0)) {
        float* Wf = (float*)lds;
        float* tile = (float*)(lds + 49152);
        for (int i = tid; i < 12 * 1024; i += NTHR) { const int j = i >> 10, k = i & 1023; Wf[i] = fox_w_in[(size_t)k * FOX_IN + 4608 + j]; }
        __syncthreads();
        for (int row = c * 8 + wid; row < MROWS; row += G * 8) {
            f32x4 y[4];
            rms_row(x + (size_t)row * DM, norm_g, h0 + (size_t)row * DM, lane, y);
            float myv = 0.f;
#pragma unroll
            for (int j = 0; j < 12; ++j) { float a = 0.f;
#pragma unroll
                for (int i = 0; i < 4; ++i) { const f32x4 w = *(const f32x4*)(Wf + j * 1024 + 256 * i + 4 * lane); a += y[i][0] * w[0] + y[i][1] * w[1] + y[i][2] * w[2] + y[i][3] * w[3]; }
                a = wave_sum(a); if (lane == j) myv = a; }
            if (lane < 12) { const float t = myv + fox_b_f[lane];
                const float ls = t >= 0.f ? -log1pf(expf(-t)) : t - log1pf(expf(t));
                const int b = row / SEQ, s = row % SEQ; cs[((size_t)b * NH + lane) * SEQ + s] = ls; }
        }
        for (int row = c * 8 + wid; row < NB * NMEM; row += G * 8) { f32x4 y[4]; rms_row(mem + (size_t)row * DM, mem_norm_g, memn + (size_t)row * DM, lane, y); }
        for (int i = c * NTHR + tid; i < SEQ * 32; i += G * NTHR) { const int pos = i >> 5, j = i & 31;
            const float inv = 1.0f / powf(10000.0f, (float)j / 32.0f); const float ang = (float)pos * inv;
            rot[2 * i] = cosf(ang); rot[2 * i + 1] = sinf(ang); }
        int tc = 0;
        transpose_tiles(fox_w_in, FOX_IN, DM, NPROJ0, Wt_in, tile, tc, G, c, MapL0());
        transpose_tiles(w_mem_kv, 1024, DM, 1024, Wt_kv, tile, tc, G, c, MapId());
        transpose_tiles(w_out, DM, INNER, DM, Wt_out, tile, tc, G, c, MapId());
        __syncthreads();
    }
    SEAM(0);
    if (IN(1)) {
        float* wt = (float*)lds;
        for (int seq = c; seq < NB * NH; seq += G) {
            float* p = cs + (size_t)seq * SEQ + tid * 4; f32x4 v = *(const f32x4*)p;
            v[1] += v[0]; v[2] += v[1]; v[3] += v[2];
            float tot = v[3], inc = tot;
#pragma unroll
            for (int d = 1; d < 64; d <<= 1) { const float n = __shfl_up(inc, d); if (lane >= d) inc += n; }
            __syncthreads();
            if (lane == 63) wt[wid] = inc;
            __syncthreads();
            float base = inc - tot; for (int w = 0; w < wid; ++w) base += wt[w];
            v = (v + base) * SQRT_HD; *(f32x4*)p = v;
        }
        __syncthreads();
        { pg8::Gemm g{h0, Wt_in, MROWS, NPROJ0, DM, DM, DM, 1 << 30, 0}; pg8::StaticOrder S; S.init(MROWS, NPROJ0, G, c);
          pg8::EpiBf16 E{proj, PITCH}; pg8::gemm_phase<pg8::EpiBf16, pg8::StaticOrder>((PG8_LAS unsigned char*)lds, g, S, E); }
        { pg8::Gemm g{memn, Wt_kv, NB * NMEM, 1024, DM, DM, DM, 1 << 30, 0}; pg8::StaticOrder S; S.init(NB * NMEM, 1024, G, c);
          pg8::EpiBf16 E{kvm, 1024}; pg8::gemm_phase<pg8::EpiBf16, pg8::StaticOrder>((PG8_LAS unsigned char*)lds, g, S, E); }
    }
    SEAM(1);
    if (IN(2)) {
#ifndef NO_M0
        run_stream<0>(0, G, c, ws, (char*)lds);
#endif
#ifndef NO_M1
        run_stream<1>(0, G, c, ws, (char*)lds);
#endif
    }
    SEAM(2);
    if (IN(3)) {
        pg8::Gemm g{proj + L0_Q, Wt_out, MROWS, DM, INNER, PITCH, INNER, MAIN_W / 64, (L0_QM - MAIN_W) * 2}; pg8::StaticOrder S; S.init(MROWS, DM, G, c);
        pg8::EpiRes E{x, out, DM}; pg8::gemm_phase<pg8::EpiRes, pg8::StaticOrder>((PG8_LAS unsigned char*)lds, g, S, E);
    }
    SEAM(3);
    if (IN(4)) {
        float* tile = (float*)(lds + 49152);
        for (int row = c * 8 + wid; row < MROWS; row += G * 8) { f32x4 y[4]; rms_row(out + (size_t)row * DM, norm_g + DM, proj + (size_t)row * PITCH + L1_H, lane, y); }
        int tc = 0;
        transpose_tiles(ret_w_in, RET_IN, DM, NPROJ1, Wt_in, tile, tc, G, c, MapL1());
        transpose_tiles(w_mem_kv + (size_t)DM * 1024, 1024, DM, 1024, Wt_kv, tile, tc, G, c, MapId());
        transpose_tiles(w_out + (size_t)INNER * DM, DM, INNER, DM, Wt_out, tile, tc, G, c, MapId());
        __syncthreads();
    }
    SEAM(4);
    if (IN(5)) {
        { pg8::Gemm g{proj + L1_H, Wt_in, MROWS, NPROJ1, DM, PITCH, DM, 1 << 30, 0}; pg8::StaticOrder S; S.init(MROWS, NPROJ1, G, c);
          pg8::EpiRot E{proj, PITCH, rot}; pg8::gemm_phase<pg8::EpiRot, pg8::StaticOrder>((PG8_LAS unsigned char*)lds, g, S, E); }
        { pg8::Gemm g{memn, Wt_kv, NB * NMEM, 1024, DM, DM, DM, 1 << 30, 0}; pg8::StaticOrder S; S.init(NB * NMEM, 1024, G, (c + G / 2) % G);
          pg8::EpiBf16 E{kvm, 1024}; pg8::gemm_phase<pg8::EpiBf16, pg8::StaticOrder>((PG8_LAS unsigned char*)lds, g, S, E); }
    }
    SEAM(5);
    if (IN(6)) {
#ifndef NO_M2
        run_stream<2>(1, G, c, ws, (char*)lds);
#endif
#ifndef NO_M1
        run_stream<1>(1, G, c, ws, (char*)lds);
#endif
    }
    SEAM(6);
    if (IN(7)) {
        pg8::Gemm g{proj + L1_H, Wt_out, MROWS, DM, INNER, PITCH, INNER, MAIN_W / 64, (L1_QM - (L1_H + MAIN_W)) * 2}; pg8::StaticOrder S; S.init(MROWS, DM, G, c);
        pg8::EpiRes E{out, out, DM}; pg8::gemm_phase<pg8::EpiRes, pg8::StaticOrder>((PG8_LAS unsigned char*)lds, g, S, E);
    }
    SEAM(7);
    if (IN(8)) {
        for (int row = c * 8 + wid; row < MROWS; row += G * 8) {
            float* xr = out + (size_t)row * DM; f32x4 y[4]; float ss = 0.f;
#pragma unroll
            for (int i = 0; i < 4; ++i) { y[i] = *(const f32x4*)(xr + 256 * i + 4 * lane); ss += y[i][0] * y[i][0] + y[i][1] * y[i][1] + y[i][2] * y[i][2] + y[i][3] * y[i][3]; }
            ss = wave_sum(ss); const float rs = 1.0f / sqrtf(ss * (1.0f / 1024.0f) + EPS);
#pragma unroll
            for (int i = 0; i < 4; ++i) { const f32x4 gg = *(const f32x4*)(final_g + 256 * i + 4 * lane); *(f32x4*)(xr + 256 * i + 4 * lane) = y[i] * rs * gg; }
        }
    }
#undef IN
#undef SEAM
}

extern "C" void kernel_launch(void* const* d_in, const int* in_sizes, int n_in, void* d_out, int out_size, void* d_ws, size_t ws_size, hipStream_t stream) {
    static int grid = 0;
    if (grid == 0) {
        if (n_in != 10 || ws_size < WS_END) { fprintf(stderr, "kernel_launch: unexpected n_in %d / ws_size %zu\n", n_in, ws_size); grid = -1; return; }
        int dev = 0, cus = 0, per_cu = 0;
        (void)hipGetDevice(&dev); (void)hipDeviceGetAttribute(&cus, hipDeviceAttributeMultiprocessorCount, dev);
        if (hipFuncSetAttribute((const void*)mk_fwd, hipFuncAttributeMaxDynamicSharedMemorySize, LDS_BYTES) != hipSuccess) { fprintf(stderr, "kernel_launch: hipFuncSetAttribute failed\n"); grid = -1; return; }
        if (hipOccupancyMaxActiveBlocksPerMultiprocessor(&per_cu, (const void*)mk_fwd, NTHR, LDS_BYTES) != hipSuccess || per_cu < 1) { fprintf(stderr, "kernel_launch: occupancy query gives %d\n", per_cu); per_cu = 1; }
        (void)hipGetLastError();
        grid = cus * 1;
    }
    if (grid < 0) return;
    Args a{};
    for (int i = 0; i < 10; ++i) a.in[i] = (const float*)d_in[i];
    a.out = (float*)d_out; a.ws = (unsigned char*)d_ws;
#if MK_MULTI_LAUNCH
    for (int p = 0; p < 9; ++p) { a.ph_lo = p; a.ph_hi = p + 1; hipLaunchKernelGGL(mk_fwd, dim3(grid), dim3(NTHR), LDS_BYTES, stream, a); }
#else
    a.ph_lo = 0; a.ph_hi = 9;
    (void)hipMemsetAsync((unsigned char*)d_ws + WS_CTL, 0, 256, stream);
    void* kargs[] = {&a};
    hipError_t e = hipLaunchCooperativeKernel((const void*)mk_fwd, dim3(grid), dim3(NTHR), kargs, LDS_BYTES, stream);
    if (e != hipSuccess) fprintf(stderr, "kernel_launch: cooperative launch failed: %s (grid %d)\n", hipGetErrorString(e), grid);
#endif
}
```

```cpp
#include <hip/hip_runtime.h>
#include <hip/hip_bf16.h>
#include <hip/hip_cooperative_groups.h>
#include <cstdio>
#include <cstdint>
namespace cg = cooperative_groups;

#ifndef MK_MULTI_LAUNCH
#define MK_MULTI_LAUNCH 0
#endif

constexpr int NB = 8, SEQ = 2048, DM = 1024, MROWS = NB * SEQ;
constexpr int NH = 12, NHM = 4, HD = 128, NMEM = 256;
constexpr int MAIN_W = NH * HD, MEM_W = NHM * HD, INNER = MAIN_W + MEM_W;
constexpr int FOX_IN = 3 * MAIN_W + NH + MEM_W + INNER;
constexpr int RET_IN = 2 * NH * 64 + MAIN_W + MEM_W + INNER;
constexpr int PITCH = 7168;
constexpr int NPROJ0 = 7168, NPROJ1 = 5632;
constexpr int L0_Q = 0, L0_K = 1536, L0_V = 3072, L0_QM = 4608, L0_Z = 5120;
constexpr int L1_Q = 0, L1_K = 768, L1_V = 1536, L1_QM = 3072, L1_Z = 3584, L1_H = 5632;
constexpr float EPS = 1e-6f;
constexpr float SQRT_HD = 11.313708498984761f;

constexpr size_t MiB = 1u << 20;
constexpr size_t WS_WIN = 0, WS_WKV = 14 * MiB, WS_WOUT = 16 * MiB, WS_PROJ = 20 * MiB, WS_MEMN = 244 * MiB, WS_KVM = 248 * MiB,
                 WS_CS = 252 * MiB, WS_ROT = 252 * MiB + 768 * 1024, WS_CTL = 254 * MiB, WS_END = 254 * MiB + 16384;

typedef unsigned short bf16_t;
typedef short bf16x8 __attribute__((ext_vector_type(8)));
typedef short s16x4 __attribute__((ext_vector_type(4)));
typedef float f32x4 __attribute__((ext_vector_type(4)));
typedef float f32x16 __attribute__((ext_vector_type(16)));
typedef unsigned u32x4 __attribute__((ext_vector_type(4)));
typedef unsigned u32x2 __attribute__((ext_vector_type(2)));

__device__ __forceinline__ unsigned cvtpk(float lo, float hi) { unsigned r; asm volatile("v_cvt_pk_bf16_f32 %0, %1, %2" : "=v"(r) : "v"(lo), "v"(hi)); return r; }
template <int CTRL> __device__ __forceinline__ float dpp_xadd(float v) { return v + __builtin_bit_cast(float, __builtin_amdgcn_update_dpp(0, __builtin_bit_cast(int, v), CTRL, 0xf, 0xf, false)); }
__device__ __forceinline__ float bf2f(unsigned short b) { return __uint_as_float(((unsigned)b) << 16); }
__device__ __forceinline__ float silu_f(float z) { return z * __builtin_amdgcn_rcpf(1.0f + __builtin_amdgcn_exp2f(-1.4426950408889634f * z)); }

namespace pg8 {
#define PG8_LAS __attribute__((address_space(3)))
constexpr int BM = 256, BK = 64, HALF = 128, HTB = HALF * BK * 2, STAGE_BYTES = 8 * HTB, NXCD = 8, WGM = 8;
__host__ __device__ __forceinline__ int lds_byte(int r, int c) { const int st = (r >> 4) * 2 + (c >> 5), rr = r & 15, cc = c & 31, ob = rr * 64 + cc * 2; return st * 1024 + (ob ^ (((ob >> 9) & 1) << 5)); }
__host__ __device__ __forceinline__ void stage_rc(int b, int& R, int& C) { const int st = b / 1024, sb = b % 1024, swz = sb ^ (((sb >> 9) & 1) << 5); R = (st >> 1) * 16 + swz / 64; C = (st & 1) * 32 + (swz % 64) / 2; }
__host__ __device__ __forceinline__ int perm32(int rho) { const int n = rho >> 4, i = rho & 15; return 8 * (i >> 2) + 4 * n + (i & 3); }
struct Unit { int pm, pn; };
struct Gemm { const bf16_t* A; const bf16_t* Bt; int M, N, K, lda, ldb, kj_tile, kj_bytes; };
struct StaticOrder {
    int nM, nN, nwg, G, c, rep;
    __host__ __device__ void init(int M, int N, int G_, int c_, int rep_ = 1) { nM = M / BM; nN = N / BM; nwg = nM * nN; G = G_; c = c_; rep = rep_; }
    __host__ __device__ bool next(int i, Unit& u) const {
        const long L = (long)i * G + c; if (L >= (long)nwg * rep) return false;
        int wgid = (int)(L % nwg); { const int q = nwg / NXCD, r = nwg % NXCD, xcd = wgid % NXCD, off = wgid / NXCD; wgid = (xcd < r ? xcd * (q + 1) : r * (q + 1) + (xcd - r) * q) + off; }
        const int nig = WGM * nN, gid = wgid / nig, fm = gid * WGM, gsz = (nM - fm) < WGM ? (nM - fm) : WGM;
        u.pm = fm + ((wgid % nig) % gsz); u.pn = (wgid % nig) / gsz; return true;
    }
};
struct EpiBf16 {
    bf16_t* O; int ldc;
    __device__ __forceinline__ void operator()(const f32x4 (&acc)[2][2][4][2], const Unit& u, int wr, int wc, int fr, int fq) const {
        const int row0 = u.pm * BM + wr * 64 + fr; const int col0 = u.pn * BM + wc * 32 + 8 * fq;
#pragma unroll
        for (int ai = 0; ai < 2; ++ai)
#pragma unroll
            for (int m = 0; m < 4; ++m) { bf16_t* rowp = O + (size_t)(row0 + ai * HALF + m * 16) * ldc + col0;
#pragma unroll
                for (int bj = 0; bj < 2; ++bj) { const f32x4 v0 = acc[ai][bj][m][0], v1 = acc[ai][bj][m][1];
                    u32x4 w; w.x = cvtpk(v0[0], v0[1]); w.y = cvtpk(v0[2], v0[3]); w.z = cvtpk(v1[0], v1[1]); w.w = cvtpk(v1[2], v1[3]);
                    *(u32x4*)(rowp + bj * HALF) = w; } }
    }
};
struct EpiRot {
    bf16_t* O; int ldc; const float* rot;
    __device__ __forceinline__ void operator()(const f32x4 (&acc)[2][2][4][2], const Unit& u, int wr, int wc, int fr, int fq) const {
        const int row0 = u.pm * BM + wr * 64 + fr; const int col0 = u.pn * BM + wc * 32 + 8 * fq;
        const bool isrot = u.pn < 6; const float sc = (u.pn >= 3 && u.pn < 6) ? 0.125f : 1.0f;
        const int i0 = (wc & 1) * 16 + 4 * fq;
#pragma unroll
        for (int ai = 0; ai < 2; ++ai)
#pragma unroll
            for (int m = 0; m < 4; ++m) { const int row = row0 + ai * HALF + m * 16; bf16_t* rowp = O + (size_t)row * ldc + col0;
                f32x4 cs0 = {1.f, 0.f, 1.f, 0.f}, cs1 = {1.f, 0.f, 1.f, 0.f};
                if (isrot) { const float* rp = rot + ((size_t)(row & (SEQ - 1)) * 32 + i0) * 2; cs0 = *(const f32x4*)rp; cs1 = *(const f32x4*)(rp + 4); }
#pragma unroll
                for (int bj = 0; bj < 2; ++bj) { f32x4 v0 = acc[ai][bj][m][0], v1 = acc[ai][bj][m][1];
                    if (isrot) {
                        const float a0 = v0[0] * cs0[0] - v0[1] * cs0[1], b0 = v0[0] * cs0[1] + v0[1] * cs0[0];
                        const float a1 = v0[2] * cs0[2] - v0[3] * cs0[3], b1 = v0[2] * cs0[3] + v0[3] * cs0[2];
                        const float a2 = v1[0] * cs1[0] - v1[1] * cs1[1], b2 = v1[0] * cs1[1] + v1[1] * cs1[0];
                        const float a3 = v1[2] * cs1[2] - v1[3] * cs1[3], b3 = v1[2] * cs1[3] + v1[3] * cs1[2];
                        v0 = (f32x4){a0 * sc, b0 * sc, a1 * sc, b1 * sc}; v1 = (f32x4){a2 * sc, b2 * sc, a3 * sc, b3 * sc}; }
                    u32x4 w; w.x = cvtpk(v0[0], v0[1]); w.y = cvtpk(v0[2], v0[3]); w.z = cvtpk(v1[0], v1[1]); w.w = cvtpk(v1[2], v1[3]);
                    *(u32x4*)(rowp + bj * HALF) = w; } }
    }
};
struct EpiRes {
    const float* base; float* out; int ldc;
    __device__ __forceinline__ void operator()(const f32x4 (&acc)[2][2][4][2], const Unit& u, int wr, int wc, int fr, int fq) const {
        const int row0 = u.pm * BM + wr * 64 + fr; const int col0 = u.pn * BM + wc * 32 + 8 * fq;
#pragma unroll
        for (int ai = 0; ai < 2; ++ai)
#pragma unroll
            for (int m = 0; m < 4; ++m) { const size_t off = (size_t)(row0 + ai * HALF + m * 16) * ldc + col0;
#pragma unroll
                for (int bj = 0; bj < 2; ++bj) {
                    const f32x4 b0 = *(const f32x4*)(base + off + bj * HALF), b1 = *(const f32x4*)(base + off + bj * HALF + 4);
                    *(f32x4*)(out + off + bj * HALF) = b0 + acc[ai][bj][m][0]; *(f32x4*)(out + off + bj * HALF + 4) = b1 + acc[ai][bj][m][1]; } }
    }
};

template <class Epi, class Sched>
__device__ __forceinline__ void gemm_phase(PG8_LAS unsigned char* lds, const Gemm g, const Sched& S, const Epi& E) {
    const int tid = threadIdx.x, wid = __builtin_amdgcn_readfirstlane(tid >> 6), lane = tid & 63, wr = wid >> 2, wc = wid & 3, fr = lane & 15, fq = lane >> 4;
    const int K = g.K, nt = K / BK;
    unsigned voffA[2], voffB[2];
#pragma unroll
    for (int i = 0; i < 2; ++i) { int R, C; stage_rc(tid * 16 + i * 8192, R, C); const int Rb = (R & ~31) + perm32(R & 31);
        voffA[i] = (unsigned)(R * g.lda + C) * 2u; voffB[i] = (unsigned)(Rb * g.ldb + C) * 2u; }
    const size_t kstep = (size_t)(BK * 2);
    const size_t hstepA = (size_t)HALF * g.lda * 2, hstepB = (size_t)HALF * g.ldb * 2;
    const size_t tstepA = 2 * hstepA, tstepB = 2 * hstepB;
    const unsigned ldsw = (unsigned)wid * 1024u;
    const int aoff = lds_byte(wr * 64 + fr, fq * 8), boff = lds_byte(wc * 32 + fr, fq * 8);
    const int kjt = g.kj_tile; const size_t kjb = (size_t)(long)g.kj_bytes;
#define PG8_AK(t) ((size_t)(t) * kstep + (((t) >= kjt) ? kjb : (size_t)0))
#define PG8_SA(b, h) (((b) * 2 + (h)) * HTB)
#define PG8_SB(b, h) ((4 + (b) * 2 + (h)) * HTB)
#define PG8_STAGE(bufoff, gbase, voff) do { _Pragma("unroll") for (int _i = 0; _i < 2; ++_i) \
        __builtin_amdgcn_global_load_lds((const unsigned*)((const char*)(gbase) + (voff)[_i]), (PG8_LAS unsigned*)(lds + (bufoff) + ldsw + _i * 8192), 16, 0, 0); } while (0)
#define PG8_LDA(dst, b, h) do { _Pragma("unroll") for (int m = 0; m < 4; ++m) _Pragma("unroll") for (int k = 0; k < 2; ++k) dst[m][k] = *(const PG8_LAS bf16x8*)(lds + PG8_SA(b, h) + aoff + m * 2048 + k * 1024); } while (0)
#define PG8_LDB(dst, b, h) do { _Pragma("unroll") for (int n = 0; n < 2; ++n) _Pragma("unroll") for (int k = 0; k < 2; ++k) dst[n][k] = *(const PG8_LAS bf16x8*)(lds + PG8_SB(b, h) + boff + n * 2048 + k * 1024); } while (0)
#define PG8_MMA(ai, bj, At, Bt) do { __builtin_amdgcn_s_setprio(1); _Pragma("unroll") for (int m = 0; m < 4; ++m) _Pragma("unroll") for (int n = 0; n < 2; ++n) _Pragma("unroll") for (int k = 0; k < 2; ++k) \
        acc[ai][bj][m][n] = __builtin_amdgcn_mfma_f32_16x16x32_bf16(Bt[n][k], At[m][k], acc[ai][bj][m][n], 0, 0, 0); __builtin_amdgcn_s_setprio(0); } while (0)
#define PG8_WAIT_V(n) asm volatile("s_waitcnt vmcnt(" #n ")" ::: "memory")
#define PG8_WAIT_L(n) asm volatile("s_waitcnt lgkmcnt(" #n ")" ::: "memory")
#define PG8_BAR __builtin_amdgcn_s_barrier()
#define PG8_SCHED __builtin_amdgcn_sched_barrier(0)
    Unit cur, nxt; int ui = 0;
    if (!S.next(0, cur)) return;
    f32x4 acc[2][2][4][2];
#pragma unroll
    for (int a = 0; a < 2; ++a)
#pragma unroll
        for (int b = 0; b < 2; ++b)
#pragma unroll
            for (int m = 0; m < 4; ++m)
#pragma unroll
                for (int n = 0; n < 2; ++n) acc[a][b][m][n] = (f32x4){0.f, 0.f, 0.f, 0.f};
    bf16x8 At[4][2], B0[2][2], B1[2][2];
    const char* cA = (const char*)g.A + (size_t)cur.pm * tstepA; const char* cB = (const char*)g.Bt + (size_t)cur.pn * tstepB;
    PG8_STAGE(PG8_SB(0, 0), cB, voffB); PG8_STAGE(PG8_SB(0, 1), cB + hstepB, voffB); PG8_STAGE(PG8_SA(0, 0), cA, voffA); PG8_STAGE(PG8_SA(0, 1), cA + hstepA, voffA);
    if (wr == 1) PG8_BAR;
    PG8_WAIT_V(2); PG8_BAR;
    PG8_STAGE(PG8_SB(1, 0), cB + kstep, voffB); PG8_STAGE(PG8_SA(1, 0), cA + kstep, voffA); PG8_STAGE(PG8_SB(1, 1), cB + hstepB + kstep, voffB);
    PG8_WAIT_V(6); PG8_BAR;
    for (;;) {
        const bool has_next = S.next(ui + 1, nxt);
        const char* nA = has_next ? (const char*)g.A + (size_t)nxt.pm * tstepA : cA; const char* nB = has_next ? (const char*)g.Bt + (size_t)nxt.pn * tstepB : cB;
        for (int t = 0; t < nt; t += 2) {
            const bool last = (t == nt - 2);
            const char* a1 = cA + PG8_AK(t + 1);
            const char* a2 = last ? nA : cA + PG8_AK(t + 2); const char* b2 = last ? nB : cB + (size_t)(t + 2) * kstep;
            const char* a3 = a2 + kstep; const char* b3 = b2 + kstep;
            PG8_LDB(B0, 0, 0); PG8_LDB(B1, 0, 1); PG8_SCHED; PG8_LDA(At, 0, 0); PG8_STAGE(PG8_SA(1, 1), a1 + hstepA, voffA);
            PG8_WAIT_V(8); PG8_WAIT_L(0); PG8_BAR; PG8_MMA(0, 0, At, B0); PG8_MMA(0, 1, At, B1); PG8_BAR; PG8_SCHED;
            PG8_LDA(At, 0, 1); PG8_STAGE(PG8_SB(0, 0), b2, voffB); PG8_STAGE(PG8_SB(0, 1), b2 + hstepB, voffB); PG8_STAGE(PG8_SA(0, 0), a2, voffA);
            PG8_WAIT_V(8); PG8_WAIT_L(0); PG8_BAR; PG8_MMA(1, 0, At, B0); PG8_MMA(1, 1, At, B1); PG8_BAR; PG8_SCHED;
            PG8_LDB(B0, 1, 0); PG8_LDB(B1, 1, 1); PG8_SCHED; PG8_LDA(At, 1, 0); PG8_STAGE(PG8_SA(0, 1), a2 + hstepA, voffA);
            PG8_WAIT_V(8); PG8_WAIT_L(0); PG8_BAR; PG8_MMA(0, 0, At, B0); PG8_MMA(0, 1, At, B1); PG8_BAR; PG8_SCHED;
            PG8_LDA(At, 1, 1); PG8_STAGE(PG8_SB(1, 0), b3, voffB); PG8_STAGE(PG8_SB(1, 1), b3 + hstepB, voffB); PG8_STAGE(PG8_SA(1, 0), a3, voffA);
            PG8_WAIT_V(8); PG8_WAIT_L(0); PG8_BAR; PG8_MMA(1, 0, At, B0); PG8_MMA(1, 1, At, B1); PG8_BAR; PG8_SCHED;
        }
        if (wr == 0) PG8_BAR;
        E(acc, cur, wr, wc, fr, fq);
        if (!has_next) break;
#pragma unroll
        for (int a = 0; a < 2; ++a)
#pragma unroll
            for (int b = 0; b < 2; ++b)
#pragma unroll
                for (int m = 0; m < 4; ++m)
#pragma unroll
                    for (int n = 0; n < 2; ++n) acc[a][b][m][n] = (f32x4){0.f, 0.f, 0.f, 0.f};
        cur = nxt; cA = nA; cB = nB; ++ui;
        if (wr == 1) PG8_BAR;
    }
    PG8_WAIT_V(0);
    PG8_BAR;
#undef PG8_AK
#undef PG8_SA
#undef PG8_SB
#undef PG8_STAGE
#undef PG8_LDA
#undef PG8_LDB
#undef PG8_MMA
#undef PG8_WAIT_V
#undef PG8_WAIT_L
#undef PG8_BAR
#undef PG8_SCHED
}
}

namespace att {
constexpr int NW = 8, QBLK = 32, KVBLK = 64, QB = NW * QBLK, D = 128;
constexpr int SHM_V = KVBLK * D * 2, SHM_K = KVBLK * D * 2;
constexpr int OFF_WS = 2 * SHM_V + 2 * SHM_K, OFF_CS = OFF_WS + NW * 64 * 4, OFF_STG = OFF_CS + 2 * SEQ * 4, STG_LD = 132, LDS_BYTES = OFF_STG + NW * 16 * STG_LD * 4;
constexpr float SCALE = 0.08838834764831845f;
constexpr float THR = 8.f;
constexpr int LDQ = PITCH;
#define KSWZ(row, colB) ((row) * 256 + ((colB) ^ (((row) & 7) << 4)))
#define SBAR() __builtin_amdgcn_sched_barrier(0)
__device__ __forceinline__ int v_st(int k, int c) { const int kk = (k & ~0xC) | ((k & 4) << 1) | ((k & 8) >> 1); return ((kk >> 3) * 4 + (c >> 5)) * 512 + ((kk & 7) * 32 + (c & 31)) * 2; }
__device__ __forceinline__ int v_rd_base(int lane) { return ((lane & 3) << 3) | (((lane >> 2) & 3) << 6) | (((lane >> 4) & 1) << 5) | (((lane >> 5) & 1) << 8); }
constexpr int v_rd_off(int d0, int ks, int half) { return d0 * 512 + ks * 4096 + half * 2048; }
__device__ __forceinline__ int crow(int r, int hi) { return (r & 3) + 8 * (r >> 2) + 4 * hi; }
__device__ __forceinline__ bf16x8 load8(const bf16_t* p) { return *reinterpret_cast<const bf16x8*>(p); }
__device__ __forceinline__ void mask_tile(f32x16& p0, f32x16& p1, int dq) {
    const float NEG = -__builtin_inff();
#pragma unroll
    for (int r = 0; r < 16; ++r) {
        const int c = (r & 3) + 8 * (r >> 2);
        if (dq - c < 0) p0[r] = NEG;
        if (dq - c - 32 < 0) p1[r] = NEG;
    }
}
__device__ __forceinline__ void bias_tile(f32x16& p0, f32x16& p1, const float* cb, float cq) {
#pragma unroll
    for (int j = 0; j < 4; ++j) { const f32x4 c0 = *(const f32x4*)(cb + 8 * j), c1 = *(const f32x4*)(cb + 8 * j + 32);
#pragma unroll
        for (int i = 0; i < 4; ++i) { p0[4 * j + i] = (p0[4 * j + i] + cq) - c0[i]; p1[4 * j + i] = (p1[4 * j + i] + cq) - c1[i]; }
        SBAR(); }
}
__device__ __forceinline__ void decay_tile(f32x16& p0, f32x16& p1, int dq, float lg2, float g1, float g2, float g3, float g32, bool needmask) {
    const float e0 = lg2 * (float)dq;
#pragma unroll
    for (int j = 0; j < 4; ++j) { const float f0 = __builtin_amdgcn_exp2f(fmaf(-lg2, (float)(8 * j), e0)), f1 = f0 * g1, f2 = f0 * g2, f3 = f0 * g3;
        p0[4 * j + 0] *= f0; p0[4 * j + 1] *= f1; p0[4 * j + 2] *= f2; p0[4 * j + 3] *= f3;
        p1[4 * j + 0] *= f0 * g32; p1[4 * j + 1] *= f1 * g32; p1[4 * j + 2] *= f2 * g32; p1[4 * j + 3] *= f3 * g32; }
    if (needmask) {
#pragma unroll
        for (int r = 0; r < 16; ++r) { const int c = (r & 3) + 8 * (r >> 2); if (dq - c < 0) p0[r] = 0.f; if (dq - c - 32 < 0) p1[r] = 0.f; }
    }
}
__device__ __forceinline__ void partialSM(f32x16& p0, f32x16& p1, float& m_reg, float& mn, float& alpha) {
    float pmax = p0[0];
#pragma unroll
    for (int r = 1; r < 16; ++r) pmax = fmaxf(pmax, p0[r]);
#pragma unroll
    for (int r = 0; r < 16; ++r) pmax = fmaxf(pmax, p1[r]);
    { auto rr = __builtin_amdgcn_permlane32_swap(__float_as_uint(pmax), __float_as_uint(pmax), false, false);
      pmax = fmaxf(__uint_as_float(rr[0]), __uint_as_float(rr[1])); }
    constexpr float C2 = 1.4426950408889634f * SCALE;
    if (__builtin_expect(__all((pmax - m_reg) * SCALE <= THR), 1)) { mn = m_reg; alpha = 1.f; }
    else { mn = fmaxf(m_reg, pmax); alpha = __builtin_amdgcn_exp2f((m_reg - mn) * C2); m_reg = mn; }
    const float mnL = -mn * C2;
#pragma unroll
    for (int r = 0; r < 16; ++r) p0[r] = fmaf(p0[r], C2, mnL);
#pragma unroll
    for (int r = 0; r < 16; ++r) p1[r] = fmaf(p1[r], C2, mnL);
#pragma unroll
    for (int r = 0; r < 16; ++r) p0[r] = __builtin_amdgcn_exp2f(p0[r]);
}
#define PK4(P, B_, OUT) do { unsigned a0 = cvtpk(P[B_+0], P[B_+1]), a1 = cvtpk(P[B_+2], P[B_+3]);                          \
        unsigned b0 = cvtpk(P[B_+4], P[B_+5]), b1 = cvtpk(P[B_+6], P[B_+7]);                                             \
        auto r0 = __builtin_amdgcn_permlane32_swap(a0, b0, false, false); auto r1 = __builtin_amdgcn_permlane32_swap(a1, b1, false, false); \
        u32x4 w = {r0[0], r1[0], r0[1], r1[1]}; OUT = *reinterpret_cast<bf16x8*>(&w); } while (0)
template <bool SOFTMAX>
__device__ __forceinline__ void finishSM(f32x16& p0, f32x16& p1, float alpha, float& l_reg, bf16x8& pa0, bf16x8& pa1, bf16x8& pa2, bf16x8& pa3) {
    if (SOFTMAX) {
#pragma unroll
        for (int r = 0; r < 16; ++r) p1[r] = __builtin_amdgcn_exp2f(p1[r]);
        float ps = 0;
#pragma unroll
        for (int r = 0; r < 16; ++r) ps += p0[r];
#pragma unroll
        for (int r = 0; r < 16; ++r) ps += p1[r];
        { auto rr = __builtin_amdgcn_permlane32_swap(__float_as_uint(ps), __float_as_uint(ps), false, false);
          ps = __uint_as_float(rr[0]) + __uint_as_float(rr[1]); }
        l_reg = l_reg * alpha + ps;
    }
    PK4(p0, 0, pa0); PK4(p0, 8, pa1); PK4(p1, 0, pa2); PK4(p1, 8, pa3);
}
#undef PK4
template <int KB, int NQF>
__device__ __forceinline__ void qkt(f32x16& p0, f32x16& p1, const char* K_lds, int r32, int hi, const bf16x8* qr) {
    p0 = f32x16{}; p1 = f32x16{};
    const char* kb[4];
#pragma unroll
    for (int dd = 0; dd < 4; ++dd) kb[dd] = K_lds + KB * SHM_K + KSWZ(r32, (dd * 16 + hi * 8) * 2);
#pragma unroll
    for (int d0 = 0; d0 < NQF; ++d0) { const char* a = kb[d0 & 3] + (d0 >> 2) * 128;
        bf16x8 b0 = *reinterpret_cast<const bf16x8*>(a);
        bf16x8 b1 = *reinterpret_cast<const bf16x8*>(a + 32 * 256);
        p0 = __builtin_amdgcn_mfma_f32_32x32x16_bf16(b0, qr[d0], p0, 0, 0, 0);
        p1 = __builtin_amdgcn_mfma_f32_32x32x16_bf16(b1, qr[d0], p1, 0, 0, 0); }
}
template <int VB>
__device__ __forceinline__ void pv_tile(f32x16* o, int vb0, bf16x8 pa0, bf16x8 pa1, bf16x8 pa2, bf16x8 pa3) {
#define TRRD(dst, off) asm volatile("ds_read_b64_tr_b16 %0, %1 offset:%2" : "=&v"(dst) : "v"(vb0), "i"(off) : "memory")
#define PV_D0(d0) do { s16x4 l0, l1, l2, l3, h0, h1, h2, h3; constexpr int b_ = VB * SHM_V + v_rd_off(d0, 0, 0); \
        TRRD(l0, b_); TRRD(h0, b_ + 2048); TRRD(l1, b_ + 4096); TRRD(h1, b_ + 6144); TRRD(l2, b_ + 8192); TRRD(h2, b_ + 10240); TRRD(l3, b_ + 12288); TRRD(h3, b_ + 14336); \
        asm volatile("s_waitcnt lgkmcnt(0)" ::: "memory"); SBAR();   \
        o[d0] = __builtin_amdgcn_mfma_f32_32x32x16_bf16(pa0, (bf16x8){l0[0], l0[1], l0[2], l0[3], h0[0], h0[1], h0[2], h0[3]}, o[d0], 0, 0, 0);   \
        o[d0] = __builtin_amdgcn_mfma_f32_32x32x16_bf16(pa1, (bf16x8){l1[0], l1[1], l1[2], l1[3], h1[0], h1[1], h1[2], h1[3]}, o[d0], 0, 0, 0);   \
        o[d0] = __builtin_amdgcn_mfma_f32_32x32x16_bf16(pa2, (bf16x8){l2[0], l2[1], l2[2], l2[3], h2[0], h2[1], h2[2], h2[3]}, o[d0], 0, 0, 0);   \
        o[d0] = __builtin_amdgcn_mfma_f32_32x32x16_bf16(pa3, (bf16x8){l3[0], l3[1], l3[2], l3[3], h3[0], h3[1], h3[2], h3[3]}, o[d0], 0, 0, 0); } while (0)
    PV_D0(0); PV_D0(1); PV_D0(2); PV_D0(3);
#undef PV_D0
#undef TRRD
}

struct BlockRef { unsigned q, k, v, o, z, cs; int P0; float lg2; };
struct Seam { bf16x8 qr[8]; bf16x8 st_v0, st_v1, st_k0, st_k1; };
#define GLD8(base, off) (*(const bf16x8*)((const char*)(base) + (off)))
#define VMW() asm volatile("s_waitcnt vmcnt(0)" ::: "memory")
#define VMWN(n) asm volatile("s_waitcnt vmcnt(%0)" :: "i"(n) : "memory")
#define SLOAD_H(Kp, Vp, k0) do { S.st_v0 = GLD8((Vp) + (size_t)(k0) * (LDKV * 2), kvoff); S.st_v1 = GLD8((Vp) + (size_t)((k0) + 32) * (LDKV * 2), kvoff);              \
                         if (sc < DQ) { S.st_k0 = GLD8((Kp) + (size_t)(k0) * (LDKV * 2), kvoff); S.st_k1 = GLD8((Kp) + (size_t)((k0) + 32) * (LDKV * 2), kvoff); } } while (0)
#define SWRITE_HK(bf) do { if (sc < DQ) { *(bf16x8*)(K_lds + (bf) * SHM_K + kws) = S.st_k0; *(bf16x8*)(K_lds + (bf) * SHM_K + kws + 32 * 256) = S.st_k1; } } while (0)
#define SWRITE_HV(bf) do { *(bf16x8*)(V_lds + (bf) * SHM_V + vst0) = S.st_v0; *(bf16x8*)(V_lds + (bf) * SHM_V + vst0 + 8192) = S.st_v1; } while (0)
#define SWRITE_H(bf) do { SWRITE_HV(bf); SWRITE_HK(bf); } while (0)
template <int MODE>
__device__ __forceinline__ void mix_prime(const BlockRef& cur, const char* wsb, char* lds, Seam& S) {
    constexpr int DQ = MODE == 2 ? 64 : 128, NQF = DQ / 16, LDKV = MODE == 1 ? 1024 : PITCH;
    const int tid = threadIdx.x, wid = __builtin_amdgcn_readfirstlane(tid >> 6), lane = tid & 63, r32 = lane & 31, hi = lane >> 5;
    const int sr = tid >> 4, sc = (tid & 15) * 8, kws = KSWZ(sr, sc * 2); char* K_lds = lds + 2 * SHM_V;
    const unsigned qoff = (unsigned)(((wid * QBLK + r32) * LDQ + hi * 8) * 2), kvoff = (unsigned)((sr * LDKV + sc) * 2);
#pragma unroll
    for (int d0 = 0; d0 < NQF; ++d0) S.qr[d0] = GLD8(wsb + cur.q + d0 * 32, qoff);
    SLOAD_H(wsb + cur.k, wsb + cur.v, 0);
    if (MODE == 0) { const f32x4 c = *(const f32x4*)(wsb + cur.cs + tid * 16); *(f32x4*)((float*)(lds + OFF_CS) + tid * 4) = c; }
    VMW(); SWRITE_HK(0);
    __syncthreads();
}
template <int MODE>
__device__ __forceinline__ void mix_block(const BlockRef& cur, const BlockRef& nxt, const char* wsb, char* lds, Seam& S, int par) {
    constexpr int DQ = MODE == 2 ? 64 : 128, NQF = DQ / 16, LDKV = MODE == 1 ? 1024 : PITCH; constexpr bool CAUSAL = MODE != 1, SOFTMAX = MODE != 2;
    const int tid = threadIdx.x, wid = __builtin_amdgcn_readfirstlane(tid >> 6), lane = tid & 63, r32 = lane & 31, hi = lane >> 5;
    const int NT = CAUSAL ? cur.P0 / KVBLK + 4 : NMEM / KVBLK;
    const int qlo = cur.P0 + wid * QBLK, qm = qlo + r32 - 4 * hi;
    char* V_lds = lds; char* K_lds = lds + 2 * SHM_V;
    float* ws = (float*)(lds + OFF_WS) + wid * 64; float* li_l = ws, * al_l = ws + 32;
    const float* cs_cur = (const float*)(lds + OFF_CS) + par * SEQ; float* cs_nxt = (float*)(lds + OFF_CS) + (par ^ 1) * SEQ;
    float m_reg = -1e30f, l_reg = 0; f32x16 o[4] = {};
    const int sr = tid >> 4, sc = (tid & 15) * 8, vst0 = v_st(sr, sc), kws = KSWZ(sr, sc * 2);
    const int vb0 = (int)(uintptr_t)V_lds + v_rd_base(lane);
    const char* Kh = wsb + cur.k; const char* Vh = wsb + cur.v;
    const unsigned qoff = (unsigned)(((wid * QBLK + r32) * LDQ + hi * 8) * 2), kvoff = (unsigned)((sr * LDKV + sc) * 2), eoff = (unsigned)(((wid * QBLK + 4 * hi) * LDQ + r32) * 2);
    const float lg2 = cur.lg2;
    float g1 = 1.f, g2 = 1.f, g3 = 1.f, g32 = 1.f;
    if (MODE == 2) { g1 = __uint_as_float(__builtin_amdgcn_readfirstlane(__float_as_uint(__builtin_amdgcn_exp2f(-lg2)))); g2 = g1 * g1; g3 = g2 * g1;
        g32 = __uint_as_float(__builtin_amdgcn_readfirstlane(__float_as_uint(__builtin_amdgcn_exp2f(-32.f * lg2)))); }
#define RESC(a) do { if (SOFTMAX) { if (__any((a) < 1.f)) { if (hi == 0) al_l[r32] = (a); asm volatile("s_waitcnt lgkmcnt(0)" ::: "memory");              \
                     for (int d_ = 0; d_ < 4; ++d_) for (int r = 0; r < 16; ++r) o[d_][r] *= al_l[crow(r, hi)]; } } } while (0)
#define KBASE(t) ((t) * KVBLK)
#define SCORE_FIX(P0_, P1_, mnX, alX, t) do { const int kb_ = KBASE(t);                                                                    \
        if (MODE == 0) { bias_tile(P0_, P1_, cs_cur + kb_ + 4 * hi, cs_cur[qlo + r32]); }                                                      \
        if (MODE == 2) { decay_tile(P0_, P1_, qm - kb_, lg2, g1, g2, g3, g32, kb_ + KVBLK - 1 > qlo); }                            \
        else { if (CAUSAL && (kb_ + KVBLK - 1 > qlo)) mask_tile(P0_, P1_, qm - kb_); partialSM(P0_, P1_, m_reg, mnX, alX); } } while (0)
#define SEAM_K0() do { VMWN(NQF); SWRITE_HK(0); SBAR(); if (MODE == 0) { const f32x4 c_ = *(const f32x4*)(wsb + nxt.cs + tid * 16); *(f32x4*)(cs_nxt + tid * 4) = c_; } SBAR(); } while (0)
    f32x16 pA0, pA1, pB0, pB1; float mnA = 0, mnB = 0, alA = 1.f, alB = 1.f; bf16x8 pa0, pa1, pa2, pa3;
    SWRITE_HV(0); SBAR();
    if (NT > 1) { SLOAD_H(Kh, Vh, KBASE(1)); }
    SBAR(); qkt<0, NQF>(pA0, pA1, K_lds, r32, hi, S.qr);
    SCORE_FIX(pA0, pA1, mnA, alA, 0);
    if (NT > 1) { VMW(); SWRITE_H(1); }
    __syncthreads();
#define HALF_STEP(PX0, PX1, mnX, alX, PY0, PY1, alY, t, KB, VB, SB) do {                                                      \
        SBAR(); qkt<KB, NQF>(PX0, PX1, K_lds, r32, hi, S.qr);                                                                 \
        finishSM<SOFTMAX>(PY0, PY1, alY, l_reg, pa0, pa1, pa2, pa3); SBAR();                                                  \
        if ((t) + 1 < NT) { SLOAD_H(Kh, Vh, KBASE((t) + 1)); SBAR(); }                                                  \
        pv_tile<VB>(o, vb0, pa0, pa1, pa2, pa3); SCORE_FIX(PX0, PX1, mnX, alX, (t));                                          \
        __syncthreads();                                                                                                      \
        if ((t) + 1 < NT) { VMW(); SWRITE_H(SB); }                                                                            \
        RESC(alX); __syncthreads(); } while (0)
    for (int t = 1; t + 1 < NT; t += 2) {
        HALF_STEP(pB0, pB1, mnB, alB, pA0, pA1, alA, t, 1, 0, 0);
        HALF_STEP(pA0, pA1, mnA, alA, pB0, pB1, alB, t + 1, 0, 1, 1);
    }
    const bool even = (NT & 1) == 0;
    if (even) { SBAR(); qkt<1, NQF>(pB0, pB1, K_lds, r32, hi, S.qr); SBAR(); }
    SLOAD_H(wsb + nxt.k, wsb + nxt.v, 0);
    SBAR();
#pragma unroll
    for (int d0 = 0; d0 < NQF; ++d0) S.qr[d0] = GLD8(wsb + nxt.q + d0 * 32, qoff);
    SBAR();
    finishSM<SOFTMAX>(pA0, pA1, alA, l_reg, pa0, pa1, pa2, pa3); SBAR();
    pv_tile<0>(o, vb0, pa0, pa1, pa2, pa3);
    if (even) { SCORE_FIX(pB0, pB1, mnB, alB, NT - 1); __syncthreads(); RESC(alB);
        finishSM<SOFTMAX>(pB0, pB1, alB, l_reg, pa0, pa1, pa2, pa3); SBAR(); pv_tile<1>(o, vb0, pa0, pa1, pa2, pa3); }
    SBAR(); SEAM_K0();
    {
        float* stg = (float*)(lds + OFF_STG) + wid * (16 * STG_LD);
        if (SOFTMAX) { if (hi == 0) li_l[r32] = l_reg; }
        const int lr4 = lane >> 4, c8 = (lane & 15) * 8;
        const unsigned e2 = (unsigned)(((wid * QBLK + lr4) * LDQ + c8) * 2);
#pragma unroll
        for (int p = 0; p < 2; ++p) {
#pragma unroll
            for (int rr = 0; rr < 8; ++rr) { const int lr = (rr & 3) + 8 * (rr >> 2) + 4 * hi;
#pragma unroll
                for (int d0 = 0; d0 < 4; ++d0) stg[lr * STG_LD + d0 * 32 + r32] = o[d0][8 * p + rr]; }
            u32x4 zz[4];
#pragma unroll
            for (int i = 0; i < 4; ++i) zz[i] = *(const u32x4*)(wsb + cur.z + (size_t)(16 * p + 4 * i) * (LDQ * 2) + e2);
#pragma unroll
            for (int i = 0; i < 4; ++i) { const int lr = lr4 + 4 * i;
                const f32x4 a = *(const f32x4*)(stg + lr * STG_LD + c8), b = *(const f32x4*)(stg + lr * STG_LD + c8 + 4);
                float rn;
                if (SOFTMAX) rn = __builtin_amdgcn_rcpf(li_l[16 * p + lr]);
                else { float ss = (a[0] * a[0] + a[1] * a[1]) + (a[2] * a[2] + a[3] * a[3]) + (b[0] * b[0] + b[1] * b[1]) + (b[2] * b[2] + b[3] * b[3]);
                    ss = dpp_xadd<0xB1>(ss); ss = dpp_xadd<0x4E>(ss); ss = dpp_xadd<0x141>(ss); ss = dpp_xadd<0x140>(ss);
                    rn = __builtin_amdgcn_rsqf(ss * (1.0f / 128.0f) + EPS); }
                u32x4 w;
                w.x = cvtpk(a[0] * rn * silu_f(__uint_as_float(zz[i].x << 16)), a[1] * rn * silu_f(__uint_as_float(zz[i].x & 0xffff0000u)));
                w.y = cvtpk(a[2] * rn * silu_f(__uint_as_float(zz[i].y << 16)), a[3] * rn * silu_f(__uint_as_float(zz[i].y & 0xffff0000u)));
                w.z = cvtpk(b[0] * rn * silu_f(__uint_as_float(zz[i].z << 16)), b[1] * rn * silu_f(__uint_as_float(zz[i].z & 0xffff0000u)));
                w.w = cvtpk(b[2] * rn * silu_f(__uint_as_float(zz[i].w << 16)), b[3] * rn * silu_f(__uint_as_float(zz[i].w & 0xffff0000u)));
                *(u32x4*)((char*)wsb + cur.o + (size_t)(16 * p + 4 * i) * (LDQ * 2) + e2) = w; }
        }
    }
    __syncthreads();
#undef RESC
#undef KBASE
#undef SCORE_FIX
#undef SEAM_K0
#undef HALF_STEP
}
#undef GLD8
#undef VMW
#undef VMWN
#undef SLOAD_H
#undef SWRITE_HK
#undef SWRITE_HV
#undef SWRITE_H
}


#define XB_TMO      128
#define XB_XCNT(j)  (256  + 64 * (j))
#define XB_XSUB(j)  (1280 + 64 * (j))
#define XB_XGEN(j)  (2304 + 64 * (j))
#define XB_TOP      3328
#define XB_TOPGEN   3392
#define XCD_BAR_WORDS 3456
#define XB_SPIN_CAP (1u << 18)
#define LAS __attribute__((address_space(3)))
__device__ __forceinline__ unsigned xb_ld(unsigned* p)              { return __hip_atomic_load(p, __ATOMIC_RELAXED, __HIP_MEMORY_SCOPE_AGENT); }
__device__ __forceinline__ unsigned xb_add(unsigned* p, unsigned v) { return __hip_atomic_fetch_add(p, v, __ATOMIC_RELAXED, __HIP_MEMORY_SCOPE_AGENT); }
__device__ __forceinline__ unsigned xb_xcc_id() { return (unsigned)__builtin_amdgcn_s_getreg((3 << 11) | 20) & 0xFu; }
#define XB_SPIN(cond, bar) do { unsigned _sp = 0; while (cond) { __builtin_amdgcn_s_sleep(1); \
    if ((++_sp & 255u) == 0u) { if (xb_ld(&(bar)[XB_TMO])) break; if (_sp > XB_SPIN_CAP) { atomicAdd(&(bar)[XB_TMO], 1u); break; } } } } while (0)
struct XcdBarrier { unsigned* bar; unsigned x; volatile LAS unsigned* st; };
__device__ __forceinline__ XcdBarrier xcd_barrier_post(unsigned* bar, volatile LAS unsigned* st) {
    XcdBarrier b; b.bar = bar; b.x = xb_xcc_id(); b.st = st;
    if (threadIdx.x == 0) (void)xb_add(&bar[XB_XCNT(b.x)], 1u);
    return b;
}
__device__ __forceinline__ void xcd_barrier_complete(unsigned* bar, unsigned x, unsigned& nloc, unsigned& nx) {
    const unsigned G = gridDim.x * gridDim.y * gridDim.z;
    unsigned sum, cnt, mine, sp = 0u;
    for (;;) {
        sum = 0u; cnt = 0u; mine = 0u;
#pragma unroll
        for (unsigned j = 0; j < 16; ++j) { const unsigned c = xb_ld(&bar[XB_XCNT(j)]); sum += c; cnt += (c > 0u) ? 1u : 0u; mine = (j == x) ? c : mine; }
        if (sum == G) break;
        __builtin_amdgcn_s_sleep(1);
        if ((++sp & 255u) == 0u) { if (xb_ld(&bar[XB_TMO])) break; if (sp > XB_SPIN_CAP) { atomicAdd(&bar[XB_TMO], 1u); break; } }
    }
    nloc = mine > 0u ? mine : 1u; nx = cnt > 0u ? cnt : 1u;
}
__device__ __forceinline__ void xcd_barrier(const XcdBarrier& b) {
    asm volatile("s_waitcnt vmcnt(0)" ::: "memory");
    __syncthreads();
    if (threadIdx.x == 0) {
        unsigned* bar = b.bar;
        __builtin_amdgcn_s_waitcnt(0);
        unsigned nloc = b.st[0], nx = b.st[1];
        if (nloc == 0u) { xcd_barrier_complete(bar, b.x, nloc, nx); b.st[0] = nloc; b.st[1] = nx; }
        const unsigned old = xb_add(&bar[XB_XSUB(b.x)], 1u);
        const unsigned gen = old / nloc;
        if (old + 1u == (gen + 1u) * nloc) {
            __builtin_amdgcn_fence(__ATOMIC_RELEASE, "agent");
            asm volatile("s_waitcnt vmcnt(0)" ::: "memory");
            const unsigned og = xb_add(&bar[XB_TOP], 1u);
            const unsigned tg = og / nx;
            if (og + 1u == (tg + 1u) * nx) xb_add(&bar[XB_TOPGEN], 1u);
            else XB_SPIN(xb_ld(&bar[XB_TOPGEN]) == tg, bar);
            __builtin_amdgcn_fence(__ATOMIC_ACQUIRE, "agent");
            xb_add(&bar[XB_XGEN(b.x)], 1u);
            asm volatile("s_waitcnt vmcnt(0)" ::: "memory");
        } else {
            XB_SPIN(xb_ld(&bar[XB_XGEN(b.x)]) == gen, bar);
            __builtin_amdgcn_fence(__ATOMIC_ACQUIRE, "agent");
            asm volatile("s_waitcnt vmcnt(0)" ::: "memory");
        }
    }
    __syncthreads();
}
constexpr int NTHR = 512;
constexpr int LDS_BYTES = att::LDS_BYTES + 128;
static_assert(LDS_BYTES >= 131072 + 128 && LDS_BYTES <= 160 * 1024, "LDS budget");
struct Args { const float* in[10]; float* out; unsigned char* ws; int ph_lo, ph_hi; };

__device__ __forceinline__ float wave_sum(float v) {
    v = dpp_xadd<0xB1>(v); v = dpp_xadd<0x4E>(v); v = dpp_xadd<0x141>(v); v = dpp_xadd<0x140>(v);
    { auto r = __builtin_amdgcn_permlane16_swap(__float_as_uint(v), __float_as_uint(v), false, false); v = __uint_as_float(r[0]) + __uint_as_float(r[1]); }
    { auto r = __builtin_amdgcn_permlane32_swap(__float_as_uint(v), __float_as_uint(v), false, false); v = __uint_as_float(r[0]) + __uint_as_float(r[1]); }
    return v;
}
__device__ __forceinline__ void load_row(const float* xr, int lane, f32x4 (&y)[4]) {
#pragma unroll
    for (int i = 0; i < 4; ++i) y[i] = *(const f32x4*)(xr + 256 * i + 4 * lane);
}
__device__ __forceinline__ void rms_row(const float* g, bf16_t* outr, int lane, f32x4 (&y)[4]) {
    float ss = 0.f;
#pragma unroll
    for (int i = 0; i < 4; ++i) ss += y[i][0] * y[i][0] + y[i][1] * y[i][1] + y[i][2] * y[i][2] + y[i][3] * y[i][3];
    ss = wave_sum(ss);
    const float rs = 1.0f / sqrtf(ss * (1.0f / 1024.0f) + EPS);
#pragma unroll
    for (int i = 0; i < 4; ++i) { const f32x4 gg = *(const f32x4*)(g + 256 * i + 4 * lane); y[i] = y[i] * rs * gg;
        u32x2 w; w.x = cvtpk(y[i][0], y[i][1]); w.y = cvtpk(y[i][2], y[i][3]); *(u32x2*)(outr + 256 * i + 4 * lane) = w; }
}
template <class Map>
__device__ __forceinline__ void transpose_tiles(const float* W, int ldw, int K, int N, bf16_t* Wt, float* tile, int& tcount, int G, int c, const Map& srcmap) {
    const int tid = threadIdx.x; const int ntk = K / 128, ntn = N / 64;
    for (int t = 0; t < ntk * ntn; ++t, ++tcount) {
        if (tcount % G != c) continue;
        const int k0 = (t % ntk) * 128, n0 = (t / ntk) * 64;
        float v[16];
        { const int n = tid & 63, kk = tid >> 6; const int sn = srcmap(n0 + n);
#pragma unroll
          for (int i = 0; i < 16; ++i) v[i] = W[(size_t)(k0 + kk + 8 * i) * ldw + sn];
          __syncthreads();
#pragma unroll
          for (int i = 0; i < 16; ++i) tile[(kk + 8 * i) * 65 + n] = v[i]; }
        __syncthreads();
        { const int k = (tid & 63) * 2, nn = tid >> 6;
#pragma unroll
          for (int i = 0; i < 8; ++i) { const int n = nn + 8 * i; *(unsigned*)(Wt + (size_t)(n0 + n) * K + k0 + k) = cvtpk(tile[k * 65 + n], tile[(k + 1) * 65 + n]); } }
    }
}
struct MapL0 { __device__ int operator()(int n) const { return n < 4608 ? n : n + 12; } };
struct MapL1 { __device__ int operator()(int n) const { if (n >= 1536) return n; const int p = n & 63; return (n & ~63) + (p & 1) * 32 + (p >> 1); } };
struct MapId { __device__ int operator()(int n) const { return n; } };

template <int MODE>
__device__ __forceinline__ bool get_block(int layer, int G, int c, int k, att::BlockRef& r) {
    if (MODE == 1) {
        const int L = c + k * G; if (L >= NB * NHM * 8) return false;
        const int qb = L & 7, hm = (L >> 3) & 3, b = L >> 5;
        const int qcol = (layer == 0 ? L0_QM : L1_QM) + hm * 128, zcol = (layer == 0 ? L0_Z : L1_Z) + MAIN_W + hm * 128;
        const unsigned rowoff = (unsigned)WS_PROJ + (unsigned)(b * SEQ + qb * 256) * (unsigned)(PITCH * 2);
        const unsigned kv = (unsigned)WS_KVM + (unsigned)(b * NMEM) * 2048u + hm * 256;
        r.q = rowoff + qcol * 2; r.o = r.q; r.z = rowoff + zcol * 2; r.k = kv; r.v = kv + 1024; r.cs = 0; r.P0 = 0; r.lg2 = 0.f;
        return true;
    } else {
        const int item = c + (k >> 1) * G; if (item >= NB * NH * 4) return false;
        const int bh = item >> 2, x = item & 3, qb = (k & 1) ? 7 - x : x, b = bh / NH, h = bh % NH;
        const unsigned rowb = (unsigned)WS_PROJ + (unsigned)(b * SEQ) * (unsigned)(PITCH * 2), row0 = rowb + (unsigned)(qb * 256) * (unsigned)(PITCH * 2);
        if (MODE == 0) {
            r.q = row0 + (L0_Q + h * 128) * 2; r.o = r.q; r.z = row0 + (L0_Z + h * 128) * 2;
            r.k = rowb + (L0_K + h * 128) * 2; r.v = rowb + (L0_V + h * 128) * 2;
            r.cs = (unsigned)WS_CS + (unsigned)bh * (SEQ * 4); r.lg2 = 0.f;
        } else {
            r.q = row0 + (L1_Q + h * 64) * 2; r.o = row0 + (L1_H + h * 128) * 2; r.z = row0 + (L1_Z + h * 128) * 2;
            r.k = rowb + (L1_K + h * 64) * 2; r.v = rowb + (L1_V + h * 128) * 2;
            r.cs = 0; r.lg2 = __uint_as_float(__builtin_amdgcn_readfirstlane(__float_as_uint(log1pf(-exp2f(-5.0f - (float)h)) * 1.4426950408889634f)));
        }
        r.P0 = qb * 256;
        return true;
    }
}
template <int MODE>
__device__ __forceinline__ void run_stream(int layer, int G, int c, const char* wsb, char* lds) {
    att::BlockRef cur, nxt; int k = 0;
    if (!get_block<MODE>(layer, G, c, 0, cur)) return;
    att::Seam S; int par = 0;
    att::mix_prime<MODE>(cur, wsb, lds, S);
    for (;;) {
        const bool has = get_block<MODE>(layer, G, c, k + 1, nxt);
        if (!has) nxt = cur;
        att::mix_block<MODE>(cur, nxt, wsb, lds, S, par);
        if (!has) break;
        cur = nxt; ++k; par ^= 1;
    }
}
__device__ __forceinline__ void p0_body(unsigned char* lds, int tid, int lane, int wid, int G, int c, const float* x, const float* mem, const float* norm_g, const float* fox_w_in,
                                        const float* fox_b_f, const float* mem_norm_g, const float* w_mem_kv, const float* w_out, bf16_t* h0, float* cs, bf16_t* memn, float* rot,
                                        bf16_t* Wt_in, bf16_t* Wt_kv, bf16_t* Wt_out) {
        float* Wf = (float*)lds;
        float* tile = (float*)(lds + 49152);
        for (int i = tid; i < 3 * 1024; i += NTHR) { const int k = i / 3, q = i % 3; const f32x4 w = *(const f32x4*)(fox_w_in + (size_t)k * FOX_IN + 4608 + 4 * q);
            Wf[(4 * q + 0) * 1024 + k] = w[0]; Wf[(4 * q + 1) * 1024 + k] = w[1]; Wf[(4 * q + 2) * 1024 + k] = w[2]; Wf[(4 * q + 3) * 1024 + k] = w[3]; }
        __syncthreads();
        { int row = c * 8 + wid; f32x4 nx[4];
          if (row < MROWS) load_row(x + (size_t)row * DM, lane, nx);
          for (; row < MROWS; row += G * 8) {
            f32x4 y[4];
#pragma unroll
            for (int i = 0; i < 4; ++i) y[i] = nx[i];
            if (row + G * 8 < MROWS) load_row(x + (size_t)(row + G * 8) * DM, lane, nx);
            rms_row(norm_g, h0 + (size_t)row * DM, lane, y);
            float myv = 0.f;
#pragma unroll
            for (int j = 0; j < 12; ++j) { float a = 0.f;
#pragma unroll
                for (int i = 0; i < 4; ++i) { const f32x4 w = *(const f32x4*)(Wf + j * 1024 + 256 * i + 4 * lane); a += y[i][0] * w[0] + y[i][1] * w[1] + y[i][2] * w[2] + y[i][3] * w[3]; }
                a = wave_sum(a); if (lane == j) myv = a; }
            if (lane < 12) { const float t = myv + fox_b_f[lane];
                const float ls = t >= 0.f ? -log1pf(expf(-t)) : t - log1pf(expf(t));
                const int b = row / SEQ, s = row % SEQ; cs[((size_t)b * NH + lane) * SEQ + s] = ls; }
          } }
        for (int row = c * 8 + wid; row < NB * NMEM; row += G * 8) { f32x4 y[4]; load_row(mem + (size_t)row * DM, lane, y); rms_row(mem_norm_g, memn + (size_t)row * DM, lane, y); }
        for (int i = c * NTHR + tid; i < SEQ * 32; i += G * NTHR) { const int pos = i >> 5, j = i & 31;
            const float inv = 1.0f / powf(10000.0f, (float)j / 32.0f); const float ang = (float)pos * inv;
            rot[2 * i] = cosf(ang); rot[2 * i + 1] = sinf(ang); }
        int tc = 0;
        transpose_tiles(fox_w_in, FOX_IN, DM, NPROJ0, Wt_in, tile, tc, G, c, MapL0());
        transpose_tiles(w_mem_kv, 1024, DM, 1024, Wt_kv, tile, tc, G, c, MapId());
        transpose_tiles(w_out, DM, INNER, DM, Wt_out, tile, tc, G, c, MapId());
        __syncthreads();
}
__device__ __forceinline__ void p4_body(unsigned char* lds, int tid, int lane, int wid, int G, int c, const float* out, const float* norm_g, const float* ret_w_in, const float* w_mem_kv,
                                        const float* w_out, bf16_t* proj, bf16_t* Wt_in, bf16_t* Wt_kv, bf16_t* Wt_out) {
        float* tile = (float*)(lds + 49152);
        { int row = c * 8 + wid; f32x4 nx[4];
          if (row < MROWS) load_row(out + (size_t)row * DM, lane, nx);
          for (; row < MROWS; row += G * 8) {
            f32x4 y[4];
#pragma unroll
            for (int i = 0; i < 4; ++i) y[i] = nx[i];
            if (row + G * 8 < MROWS) load_row(out + (size_t)(row + G * 8) * DM, lane, nx);
            rms_row(norm_g + DM, proj + (size_t)row * PITCH + L1_H, lane, y);
          } }
        int tc = 0;
        transpose_tiles(ret_w_in, RET_IN, DM, NPROJ1, Wt_in, tile, tc, G, c, MapL1());
        transpose_tiles(w_mem_kv + (size_t)DM * 1024, 1024, DM, 1024, Wt_kv, tile, tc, G, c, MapId());
        transpose_tiles(w_out + (size_t)INNER * DM, DM, INNER, DM, Wt_out, tile, tc, G, c, MapId());
        __syncthreads();
}
__global__ void __launch_bounds__(NTHR, 2) mk_fwd(Args args) {
    extern __shared__ __attribute__((aligned(16))) unsigned char lds[];
    const int tid = threadIdx.x, lane = tid & 63, wid = __builtin_amdgcn_readfirstlane(tid >> 6);
    const int G = gridDim.x, c = blockIdx.x;
    typedef const __attribute__((address_space(4))) Args* KArgP;
    KArgP ap = (KArgP)__builtin_amdgcn_kernarg_segment_ptr();
#define PH_ARGS asm volatile("" : "+s"(ap)); unsigned char* ws = ap->ws; float* out = ap->out;                                                           \
    const float* x = ap->in[0]; const float* mem = ap->in[1]; const float* norm_g = ap->in[2]; const float* fox_w_in = ap->in[3]; const float* fox_b_f = ap->in[4]; \
    const float* ret_w_in = ap->in[5]; const float* mem_norm_g = ap->in[6]; const float* w_mem_kv = ap->in[7]; const float* w_out = ap->in[8]; const float* final_g = ap->in[9]; \
    bf16_t* Wt_in = (bf16_t*)(ws + WS_WIN); bf16_t* Wt_kv = (bf16_t*)(ws + WS_WKV); bf16_t* Wt_out = (bf16_t*)(ws + WS_WOUT);                              \
    bf16_t* proj = (bf16_t*)(ws + WS_PROJ); bf16_t* memn = (bf16_t*)(ws + WS_MEMN); bf16_t* kvm = (bf16_t*)(ws + WS_KVM);                                   \
    float* cs = (float*)(ws + WS_CS); float* rot = (float*)(ws + WS_ROT); bf16_t* h0 = (bf16_t*)out;                                                       \
    (void)x; (void)mem; (void)norm_g; (void)fox_w_in; (void)fox_b_f; (void)ret_w_in; (void)mem_norm_g; (void)w_mem_kv; (void)w_out; (void)final_g;       \
    (void)Wt_in; (void)Wt_kv; (void)Wt_out; (void)proj; (void)memn; (void)kvm; (void)cs; (void)rot; (void)h0
    const int lo = ap->ph_lo, hi_ = ap->ph_hi;
#ifndef PROBE_PHASE
#define PROBE_PHASE -1
#endif
#if PROBE_PHASE >= 0
#define REPS(k) for (int rep_ = 0; rep_ < ((k) == PROBE_PHASE ? 2 : 1); ++rep_)
#define DRY false
#else
#define REPS(k)
#define DRY false
#endif
#ifndef PH_MASK
#define PH_MASK 0x1ff
#endif
#define IN(k) (((PH_MASK >> (k)) & 1) && lo <= (k) && (k) < hi_)
    volatile LAS unsigned* bst = (volatile LAS unsigned*)((LAS unsigned char*)lds + (LDS_BYTES - 16));
    if (tid < 4) bst[tid] = 0u;
    __syncthreads();
    XcdBarrier xbar; xbar.bar = (unsigned*)(ap->ws + WS_CTL); xbar.x = 0; xbar.st = bst;
    if (IN(0) && IN(2)) xbar = xcd_barrier_post((unsigned*)(ap->ws + WS_CTL), bst);
#define SEAM(k) do { if (IN(k) && IN((k) + 1)) { if ((k) == 0) { cg::this_grid().sync(); } else { xcd_barrier(xbar); } } } while (0)

    if (IN(0)) { PH_ARGS;
        p0_body(lds, tid, lane, wid, G, c, x, mem, norm_g, fox_w_in, fox_b_f, mem_norm_g, w_mem_kv, w_out, h0, cs, memn, rot, Wt_in, Wt_kv, Wt_out);
        if (PROBE_PHASE == 0) p0_body(lds, tid, lane, wid, G, c, x, mem, norm_g, fox_w_in, fox_b_f, mem_norm_g, w_mem_kv, w_out, h0, cs, memn, rot, Wt_in, Wt_kv, Wt_out);
    }
    SEAM(0);
    if (IN(1)) { PH_ARGS;
        float* wt = (float*)lds;
        for (int seq = c; seq < NB * NH; seq += G) {
            float* p = cs + (size_t)seq * SEQ + tid * 4; f32x4 v = *(const f32x4*)p;
            v[1] += v[0]; v[2] += v[1]; v[3] += v[2];
            float tot = v[3], inc = tot;
#pragma unroll
            for (int d = 1; d < 64; d <<= 1) { const float n = __shfl_up(inc, d); if (lane >= d) inc += n; }
            __syncthreads();
            if (lane == 63) wt[wid] = inc;
            __syncthreads();
            float base = inc - tot; for (int w = 0; w < wid; ++w) base += wt[w];
            v = (v + base) * SQRT_HD; *(f32x4*)p = v;
        }
        __syncthreads();
        { pg8::Gemm g{h0, Wt_in, MROWS, NPROJ0, DM, DM, DM, 1 << 30, 0}; pg8::StaticOrder S; S.init(MROWS, NPROJ0, G, c, PROBE_PHASE == 1 ? 2 : 1);
          pg8::EpiBf16 E{proj, PITCH}; pg8::gemm_phase<pg8::EpiBf16, pg8::StaticOrder>((PG8_LAS unsigned char*)lds, g, S, E); }
        { pg8::Gemm g{memn, Wt_kv, NB * NMEM, 1024, DM, DM, DM, 1 << 30, 0}; pg8::StaticOrder S; S.init(NB * NMEM, 1024, G, c);
          pg8::EpiBf16 E{kvm, 1024}; pg8::gemm_phase<pg8::EpiBf16, pg8::StaticOrder>((PG8_LAS unsigned char*)lds, g, S, E); }
    }
    SEAM(1);
    if (IN(2)) { PH_ARGS;
#ifndef NO_M0
        run_stream<0>(0, G, c, (const char*)ws, (char*)lds);
#endif
#ifndef NO_M1
        run_stream<1>(0, G, c, (const char*)ws, (char*)lds);
#endif
    }
    SEAM(2);
    if (IN(3)) { PH_ARGS;
        pg8::Gemm g{proj + L0_Q, Wt_out, MROWS, DM, INNER, PITCH, INNER, MAIN_W / 64, (L0_QM - MAIN_W) * 2}; pg8::StaticOrder S; S.init(MROWS, DM, G, c, PROBE_PHASE == 3 ? 2 : 1);
        pg8::EpiRes E{x, out, DM}; pg8::gemm_phase<pg8::EpiRes, pg8::StaticOrder>((PG8_LAS unsigned char*)lds, g, S, E);
    }
    SEAM(3);
    if (IN(4)) { PH_ARGS;
        p4_body(lds, tid, lane, wid, G, c, out, norm_g, ret_w_in, w_mem_kv, w_out, proj, Wt_in, Wt_kv, Wt_out);
        if (PROBE_PHASE == 4) p4_body(lds, tid, lane, wid, G, c, out, norm_g, ret_w_in, w_mem_kv, w_out, proj, Wt_in, Wt_kv, Wt_out);
    }
    SEAM(4);
    if (IN(5)) { PH_ARGS;
        { pg8::Gemm g{proj + L1_H, Wt_in, MROWS, NPROJ1, DM, PITCH, DM, 1 << 30, 0}; pg8::StaticOrder S; S.init(MROWS, NPROJ1, G, c, PROBE_PHASE == 5 ? 2 : 1);
          pg8::EpiRot E{proj, PITCH, rot}; pg8::gemm_phase<pg8::EpiRot, pg8::StaticOrder>((PG8_LAS unsigned char*)lds, g, S, E); }
        { pg8::Gemm g{memn, Wt_kv, NB * NMEM, 1024, DM, DM, DM, 1 << 30, 0}; pg8::StaticOrder S; S.init(NB * NMEM, 1024, G, (c + G / 2) % G);
          pg8::EpiBf16 E{kvm, 1024}; pg8::gemm_phase<pg8::EpiBf16, pg8::StaticOrder>((PG8_LAS unsigned char*)lds, g, S, E); }
    }
    SEAM(5);
    if (IN(6)) { PH_ARGS;
#ifndef NO_M2
        if (PROBE_PHASE == 6) run_stream<2>(1, G, c, (const char*)ws, (char*)lds);
        run_stream<2>(1, G, c, (const char*)ws, (char*)lds);
#endif
#ifndef NO_M1
        run_stream<1>(1, G, c, (const char*)ws, (char*)lds);
#endif
    }
    SEAM(6);
    if (IN(7)) { PH_ARGS;
        pg8::Gemm g{proj + L1_H, Wt_out, MROWS, DM, INNER, PITCH, INNER, MAIN_W / 64, (L1_QM - (L1_H + MAIN_W)) * 2}; pg8::StaticOrder S; S.init(MROWS, DM, G, c);
        pg8::EpiRes E{out, out, DM}; pg8::gemm_phase<pg8::EpiRes, pg8::StaticOrder>((PG8_LAS unsigned char*)lds, g, S, E);
    }
    SEAM(7);
    if (IN(8)) { PH_ARGS;
        for (int row = c * 8 + wid; row < MROWS; row += G * 8) {
            float* xr = out + (size_t)row * DM; f32x4 y[4]; float ss = 0.f;
#pragma unroll
            for (int i = 0; i < 4; ++i) { y[i] = *(const f32x4*)(xr + 256 * i + 4 * lane); ss += y[i][0] * y[i][0] + y[i][1] * y[i][1] + y[i][2] * y[i][2] + y[i][3] * y[i][3]; }
            ss = wave_sum(ss); const float rs = 1.0f / sqrtf(ss * (1.0f / 1024.0f) + EPS);
#pragma unroll
            for (int i = 0; i < 4; ++i) { const f32x4 gg = *(const f32x4*)(final_g + 256 * i + 4 * lane); *(f32x4*)(xr + 256 * i + 4 * lane) = y[i] * rs * gg; }
        }
    }
#undef IN
#undef SEAM
}

extern "C" void kernel_launch(void* const* d_in, const int* in_sizes, int n_in, void* d_out, int out_size, void* d_ws, size_t ws_size, hipStream_t stream) {
    static int grid = 0;
    if (grid == 0) {
        if (n_in != 10 || ws_size < WS_END) { fprintf(stderr, "kernel_launch: unexpected n_in %d / ws_size %zu\n", n_in, ws_size); grid = -1; return; }
        int dev = 0, cus = 0, per_cu = 0;
        (void)hipGetDevice(&dev); (void)hipDeviceGetAttribute(&cus, hipDeviceAttributeMultiprocessorCount, dev);
        if (hipFuncSetAttribute((const void*)mk_fwd, hipFuncAttributeMaxDynamicSharedMemorySize, LDS_BYTES) != hipSuccess) { fprintf(stderr, "kernel_launch: hipFuncSetAttribute failed\n"); grid = -1; return; }
        if (hipOccupancyMaxActiveBlocksPerMultiprocessor(&per_cu, (const void*)mk_fwd, NTHR, LDS_BYTES) != hipSuccess || per_cu < 1) { fprintf(stderr, "kernel_launch: occupancy query gives %d\n", per_cu); per_cu = 1; }
        (void)hipGetLastError();
        grid = cus * 1;
    }
    if (grid < 0) return;
    Args a{};
    for (int i = 0; i < 10; ++i) a.in[i] = (const float*)d_in[i];
    a.out = (float*)d_out; a.ws = (unsigned char*)d_ws;
#if MK_MULTI_LAUNCH
    for (int p = 0; p < 9; ++p) { a.ph_lo = p; a.ph_hi = p + 1; hipLaunchKernelGGL(mk_fwd, dim3(grid), dim3(NTHR), LDS_BYTES, stream, a); }
#else
    a.ph_lo = 0; a.ph_hi = 9;
    (void)hipMemsetAsync((unsigned char*)d_ws + WS_CTL, 0, 16384, stream);
    void* kargs[] = {&a};
    hipError_t e = hipLaunchCooperativeKernel((const void*)mk_fwd, dim3(grid), dim3(NTHR), kargs, LDS_BYTES, stream);
    if (e != hipSuccess) fprintf(stderr, "kernel_launch: cooperative launch failed: %s (grid %d)\n", hipGetErrorString(e), grid);
#endif
}
```

```cpp
#include <hip/hip_runtime.h>
#include <hip/hip_bf16.h>
#include <hip/hip_cooperative_groups.h>
#include <cstdio>
#include <cstdint>
namespace cg = cooperative_groups;

#ifndef MK_MULTI_LAUNCH
#define MK_MULTI_LAUNCH 0
#endif

constexpr int NB = 8, SEQ = 2048, DM = 1024, MROWS = NB * SEQ;
constexpr int NH = 12, NHM = 4, HD = 128, NMEM = 256;
constexpr int MAIN_W = NH * HD, MEM_W = NHM * HD, INNER = MAIN_W + MEM_W;
constexpr int FOX_IN = 3 * MAIN_W + NH + MEM_W + INNER;
constexpr int RET_IN = 2 * NH * 64 + MAIN_W + MEM_W + INNER;
constexpr int PITCH = 7168;
constexpr int NPROJ0 = 7168, NPROJ1 = 5632;
constexpr int L0_Q = 0, L0_K = 1536, L0_V = 3072, L0_QM = 4608, L0_Z = 5120;
constexpr int L1_Q = 0, L1_K = 768, L1_V = 1536, L1_QM = 3072, L1_Z = 3584, L1_H = 5632;
constexpr float EPS = 1e-6f;
constexpr float SQRT_HD = 11.313708498984761f;

constexpr size_t MiB = 1u << 20;
constexpr size_t WS_WIN = 0, WS_WKV = 14 * MiB, WS_WOUT = 16 * MiB, WS_PROJ = 20 * MiB, WS_MEMN = 244 * MiB, WS_KVM = 248 * MiB,
                 WS_CS = 252 * MiB, WS_ROT = 252 * MiB + 768 * 1024, WS_CTL = 254 * MiB, WS_END = 254 * MiB + 16384;

typedef unsigned short bf16_t;
typedef short bf16x8 __attribute__((ext_vector_type(8)));
typedef short s16x4 __attribute__((ext_vector_type(4)));
typedef float f32x4 __attribute__((ext_vector_type(4)));
typedef float f32x16 __attribute__((ext_vector_type(16)));
typedef unsigned u32x4 __attribute__((ext_vector_type(4)));
typedef unsigned u32x2 __attribute__((ext_vector_type(2)));

__device__ __forceinline__ unsigned cvtpk(float lo, float hi) { unsigned r; asm volatile("v_cvt_pk_bf16_f32 %0, %1, %2" : "=v"(r) : "v"(lo), "v"(hi)); return r; }
template <int CTRL> __device__ __forceinline__ float dpp_xadd(float v) { return v + __builtin_bit_cast(float, __builtin_amdgcn_update_dpp(0, __builtin_bit_cast(int, v), CTRL, 0xf, 0xf, false)); }
__device__ __forceinline__ float bf2f(unsigned short b) { return __uint_as_float(((unsigned)b) << 16); }
__device__ __forceinline__ float silu_f(float z) { return z * __builtin_amdgcn_rcpf(1.0f + __builtin_amdgcn_exp2f(-1.4426950408889634f * z)); }

namespace pg8 {
#define PG8_LAS __attribute__((address_space(3)))
constexpr int BM = 256, BK = 64, HALF = 128, HTB = HALF * BK * 2, STAGE_BYTES = 8 * HTB, NXCD = 8, WGM = 8;
__host__ __device__ __forceinline__ int lds_byte(int r, int c) { const int st = (r >> 4) * 2 + (c >> 5), rr = r & 15, cc = c & 31, ob = rr * 64 + cc * 2; return st * 1024 + (ob ^ (((ob >> 9) & 1) << 5)); }
__host__ __device__ __forceinline__ void stage_rc(int b, int& R, int& C) { const int st = b / 1024, sb = b % 1024, swz = sb ^ (((sb >> 9) & 1) << 5); R = (st >> 1) * 16 + swz / 64; C = (st & 1) * 32 + (swz % 64) / 2; }
__host__ __device__ __forceinline__ int perm32(int rho) { const int n = rho >> 4, i = rho & 15; return 8 * (i >> 2) + 4 * n + (i & 3); }
struct Unit { int pm, pn; };
struct Gemm { const bf16_t* A; const bf16_t* Bt; int M, N, K, lda, ldb, kj_tile, kj_bytes; };
struct StaticOrder {
    int nM, nN, nwg, G, c, rep;
    __host__ __device__ void init(int M, int N, int G_, int c_, int rep_ = 1) { nM = M / BM; nN = N / BM; nwg = nM * nN; G = G_; c = c_; rep = rep_; }
    __host__ __device__ bool next(int i, Unit& u) const {
        const long L = (long)i * G + c; if (L >= (long)nwg * rep) return false;
        int wgid = (int)(L % nwg); { const int q = nwg / NXCD, r = nwg % NXCD, xcd = wgid % NXCD, off = wgid / NXCD; wgid = (xcd < r ? xcd * (q + 1) : r * (q + 1) + (xcd - r) * q) + off; }
        const int nig = WGM * nN, gid = wgid / nig, fm = gid * WGM, gsz = (nM - fm) < WGM ? (nM - fm) : WGM;
        u.pm = fm + ((wgid % nig) % gsz); u.pn = (wgid % nig) / gsz; return true;
    }
};
struct EpiBf16 {
    bf16_t* O; int ldc;
    __device__ __forceinline__ void operator()(const f32x4 (&acc)[2][2][4][2], const Unit& u, int wr, int wc, int fr, int fq) const {
        const int row0 = u.pm * BM + wr * 64 + fr; const int col0 = u.pn * BM + wc * 32 + 8 * fq;
#pragma unroll
        for (int ai = 0; ai < 2; ++ai)
#pragma unroll
            for (int m = 0; m < 4; ++m) { bf16_t* rowp = O + (size_t)(row0 + ai * HALF + m * 16) * ldc + col0;
#pragma unroll
                for (int bj = 0; bj < 2; ++bj) { const f32x4 v0 = acc[ai][bj][m][0], v1 = acc[ai][bj][m][1];
                    u32x4 w; w.x = cvtpk(v0[0], v0[1]); w.y = cvtpk(v0[2], v0[3]); w.z = cvtpk(v1[0], v1[1]); w.w = cvtpk(v1[2], v1[3]);
                    *(u32x4*)(rowp + bj * HALF) = w; } }
    }
};
struct EpiRot {
    bf16_t* O; int ldc; const float* rot;
    __device__ __forceinline__ void operator()(const f32x4 (&acc)[2][2][4][2], const Unit& u, int wr, int wc, int fr, int fq) const {
        const int row0 = u.pm * BM + wr * 64 + fr; const int col0 = u.pn * BM + wc * 32 + 8 * fq;
        const bool isrot = u.pn < 6; const float sc = (u.pn >= 3 && u.pn < 6) ? 0.125f : 1.0f;
        const int i0 = (wc & 1) * 16 + 4 * fq;
#pragma unroll
        for (int ai = 0; ai < 2; ++ai)
#pragma unroll
            for (int m = 0; m < 4; ++m) { const int row = row0 + ai * HALF + m * 16; bf16_t* rowp = O + (size_t)row * ldc + col0;
                f32x4 cs0 = {1.f, 0.f, 1.f, 0.f}, cs1 = {1.f, 0.f, 1.f, 0.f};
                if (isrot) { const float* rp = rot + ((size_t)(row & (SEQ - 1)) * 32 + i0) * 2; cs0 = *(const f32x4*)rp; cs1 = *(const f32x4*)(rp + 4); }
#pragma unroll
                for (int bj = 0; bj < 2; ++bj) { f32x4 v0 = acc[ai][bj][m][0], v1 = acc[ai][bj][m][1];
                    if (isrot) {
                        const float a0 = v0[0] * cs0[0] - v0[1] * cs0[1], b0 = v0[0] * cs0[1] + v0[1] * cs0[0];
                        const float a1 = v0[2] * cs0[2] - v0[3] * cs0[3], b1 = v0[2] * cs0[3] + v0[3] * cs0[2];
                        const float a2 = v1[0] * cs1[0] - v1[1] * cs1[1], b2 = v1[0] * cs1[1] + v1[1] * cs1[0];
                        const float a3 = v1[2] * cs1[2] - v1[3] * cs1[3], b3 = v1[2] * cs1[3] + v1[3] * cs1[2];
                        v0 = (f32x4){a0 * sc, b0 * sc, a1 * sc, b1 * sc}; v1 = (f32x4){a2 * sc, b2 * sc, a3 * sc, b3 * sc}; }
                    u32x4 w; w.x = cvtpk(v0[0], v0[1]); w.y = cvtpk(v0[2], v0[3]); w.z = cvtpk(v1[0], v1[1]); w.w = cvtpk(v1[2], v1[3]);
                    *(u32x4*)(rowp + bj * HALF) = w; } }
    }
};
struct EpiRes {
    const float* base; float* out; int ldc;
    __device__ __forceinline__ void operator()(const f32x4 (&acc)[2][2][4][2], const Unit& u, int wr, int wc, int fr, int fq) const {
        const int row0 = u.pm * BM + wr * 64 + fr; const int col0 = u.pn * BM + wc * 32 + 8 * fq;
#pragma unroll
        for (int ai = 0; ai < 2; ++ai)
#pragma unroll
            for (int m = 0; m < 4; ++m) { const size_t off = (size_t)(row0 + ai * HALF + m * 16) * ldc + col0;
#pragma unroll
                for (int bj = 0; bj < 2; ++bj) {
                    const f32x4 b0 = *(const f32x4*)(base + off + bj * HALF), b1 = *(const f32x4*)(base + off + bj * HALF + 4);
                    *(f32x4*)(out + off + bj * HALF) = b0 + acc[ai][bj][m][0]; *(f32x4*)(out + off + bj * HALF + 4) = b1 + acc[ai][bj][m][1]; } }
    }
};

template <class Epi, class Sched>
__device__ __forceinline__ void gemm_phase(PG8_LAS unsigned char* lds, const Gemm g, const Sched& S, const Epi& E) {
    const int tid = threadIdx.x, wid = __builtin_amdgcn_readfirstlane(tid >> 6), lane = tid & 63, wr = wid >> 2, wc = wid & 3, fr = lane & 15, fq = lane >> 4;
    const int K = g.K, nt = K / BK;
    unsigned voffA[2], voffB[2];
#pragma unroll
    for (int i = 0; i < 2; ++i) { int R, C; stage_rc(tid * 16 + i * 8192, R, C); const int Rb = (R & ~31) + perm32(R & 31);
        voffA[i] = (unsigned)(R * g.lda + C) * 2u; voffB[i] = (unsigned)(Rb * g.ldb + C) * 2u; }
    const size_t kstep = (size_t)(BK * 2);
    const size_t hstepA = (size_t)HALF * g.lda * 2, hstepB = (size_t)HALF * g.ldb * 2;
    const size_t tstepA = 2 * hstepA, tstepB = 2 * hstepB;
    const unsigned ldsw = (unsigned)wid * 1024u;
    const int aoff = lds_byte(wr * 64 + fr, fq * 8), boff = lds_byte(wc * 32 + fr, fq * 8);
    const int kjt = g.kj_tile; const size_t kjb = (size_t)(long)g.kj_bytes;
#define PG8_AK(t) ((size_t)(t) * kstep + (((t) >= kjt) ? kjb : (size_t)0))
#define PG8_SA(b, h) (((b) * 2 + (h)) * HTB)
#define PG8_SB(b, h) ((4 + (b) * 2 + (h)) * HTB)
#define PG8_STAGE(bufoff, gbase, voff) do { _Pragma("unroll") for (int _i = 0; _i < 2; ++_i) \
        __builtin_amdgcn_global_load_lds((const unsigned*)((const char*)(gbase) + (voff)[_i]), (PG8_LAS unsigned*)(lds + (bufoff) + ldsw + _i * 8192), 16, 0, 0); } while (0)
#define PG8_LDA(dst, b, h) do { _Pragma("unroll") for (int m = 0; m < 4; ++m) _Pragma("unroll") for (int k = 0; k < 2; ++k) dst[m][k] = *(const PG8_LAS bf16x8*)(lds + PG8_SA(b, h) + aoff + m * 2048 + k * 1024); } while (0)
#define PG8_LDB(dst, b, h) do { _Pragma("unroll") for (int n = 0; n < 2; ++n) _Pragma("unroll") for (int k = 0; k < 2; ++k) dst[n][k] = *(const PG8_LAS bf16x8*)(lds + PG8_SB(b, h) + boff + n * 2048 + k * 1024); } while (0)
#define PG8_MMA(ai, bj, At, Bt) do { __builtin_amdgcn_s_setprio(1); _Pragma("unroll") for (int m = 0; m < 4; ++m) _Pragma("unroll") for (int n = 0; n < 2; ++n) _Pragma("unroll") for (int k = 0; k < 2; ++k) \
        acc[ai][bj][m][n] = __builtin_amdgcn_mfma_f32_16x16x32_bf16(Bt[n][k], At[m][k], acc[ai][bj][m][n], 0, 0, 0); __builtin_amdgcn_s_setprio(0); } while (0)
#define PG8_WAIT_V(n) asm volatile("s_waitcnt vmcnt(" #n ")" ::: "memory")
#define PG8_WAIT_L(n) asm volatile("s_waitcnt lgkmcnt(" #n ")" ::: "memory")
#define PG8_BAR __builtin_amdgcn_s_barrier()
#define PG8_SCHED __builtin_amdgcn_sched_barrier(0)
    Unit cur, nxt; int ui = 0;
    if (!S.next(0, cur)) return;
    f32x4 acc[2][2][4][2];
#pragma unroll
    for (int a = 0; a < 2; ++a)
#pragma unroll
        for (int b = 0; b < 2; ++b)
#pragma unroll
            for (int m = 0; m < 4; ++m)
#pragma unroll
                for (int n = 0; n < 2; ++n) acc[a][b][m][n] = (f32x4){0.f, 0.f, 0.f, 0.f};
    bf16x8 At[4][2], B0[2][2], B1[2][2];
    const char* cA = (const char*)g.A + (size_t)cur.pm * tstepA; const char* cB = (const char*)g.Bt + (size_t)cur.pn * tstepB;
    PG8_STAGE(PG8_SB(0, 0), cB, voffB); PG8_STAGE(PG8_SB(0, 1), cB + hstepB, voffB); PG8_STAGE(PG8_SA(0, 0), cA, voffA); PG8_STAGE(PG8_SA(0, 1), cA + hstepA, voffA);
    if (wr == 1) PG8_BAR;
    PG8_WAIT_V(2); PG8_BAR;
    PG8_STAGE(PG8_SB(1, 0), cB + kstep, voffB); PG8_STAGE(PG8_SA(1, 0), cA + kstep, voffA); PG8_STAGE(PG8_SB(1, 1), cB + hstepB + kstep, voffB);
    PG8_WAIT_V(6); PG8_BAR;
    for (;;) {
        const bool has_next = S.next(ui + 1, nxt);
        const char* nA = has_next ? (const char*)g.A + (size_t)nxt.pm * tstepA : cA; const char* nB = has_next ? (const char*)g.Bt + (size_t)nxt.pn * tstepB : cB;
        for (int t = 0; t < nt; t += 2) {
            const bool last = (t == nt - 2);
            const char* a1 = cA + PG8_AK(t + 1);
            const char* a2 = last ? nA : cA + PG8_AK(t + 2); const char* b2 = last ? nB : cB + (size_t)(t + 2) * kstep;
            const char* a3 = a2 + kstep; const char* b3 = b2 + kstep;
            PG8_LDB(B0, 0, 0); PG8_LDB(B1, 0, 1); PG8_SCHED; PG8_LDA(At, 0, 0); PG8_STAGE(PG8_SA(1, 1), a1 + hstepA, voffA);
            PG8_WAIT_V(8); PG8_WAIT_L(0); PG8_BAR; PG8_MMA(0, 0, At, B0); PG8_MMA(0, 1, At, B1); PG8_BAR; PG8_SCHED;
            PG8_LDA(At, 0, 1); PG8_STAGE(PG8_SB(0, 0), b2, voffB); PG8_STAGE(PG8_SB(0, 1), b2 + hstepB, voffB); PG8_STAGE(PG8_SA(0, 0), a2, voffA);
            PG8_WAIT_V(8); PG8_WAIT_L(0); PG8_BAR; PG8_MMA(1, 0, At, B0); PG8_MMA(1, 1, At, B1); PG8_BAR; PG8_SCHED;
            PG8_LDB(B0, 1, 0); PG8_LDB(B1, 1, 1); PG8_SCHED; PG8_LDA(At, 1, 0); PG8_STAGE(PG8_SA(0, 1), a2 + hstepA, voffA);
            PG8_WAIT_V(8); PG8_WAIT_L(0); PG8_BAR; PG8_MMA(0, 0, At, B0); PG8_MMA(0, 1, At, B1); PG8_BAR; PG8_SCHED;
            PG8_LDA(At, 1, 1); PG8_STAGE(PG8_SB(1, 0), b3, voffB); PG8_STAGE(PG8_SB(1, 1), b3 + hstepB, voffB); PG8_STAGE(PG8_SA(1, 0), a3, voffA);
            PG8_WAIT_V(8); PG8_WAIT_L(0); PG8_BAR; PG8_MMA(1, 0, At, B0); PG8_MMA(1, 1, At, B1); PG8_BAR; PG8_SCHED;
        }
        if (wr == 0) PG8_BAR;
        E(acc, cur, wr, wc, fr, fq);
        if (!has_next) break;
#pragma unroll
        for (int a = 0; a < 2; ++a)
#pragma unroll
            for (int b = 0; b < 2; ++b)
#pragma unroll
                for (int m = 0; m < 4; ++m)
#pragma unroll
                    for (int n = 0; n < 2; ++n) acc[a][b][m][n] = (f32x4){0.f, 0.f, 0.f, 0.f};
        cur = nxt; cA = nA; cB = nB; ++ui;
        if (wr == 1) PG8_BAR;
    }
    PG8_WAIT_V(0);
    PG8_BAR;
#undef PG8_AK
#undef PG8_SA
#undef PG8_SB
#undef PG8_STAGE
#undef PG8_LDA
#undef PG8_LDB
#undef PG8_MMA
#undef PG8_WAIT_V
#undef PG8_WAIT_L
#undef PG8_BAR
#undef PG8_SCHED
}
}

namespace att {
constexpr int NW = 8, QBLK = 32, KVBLK = 64, QB = NW * QBLK, D = 128;
constexpr int SHM_V = KVBLK * D * 2, SHM_K = KVBLK * D * 2;
constexpr int OFF_WS = 2 * SHM_V + 2 * SHM_K, OFF_CS = OFF_WS + NW * 64 * 4, OFF_STG = OFF_CS + 2 * SEQ * 4, STG_LD = 132, LDS_BYTES = OFF_STG + NW * 16 * STG_LD * 4;
constexpr float SCALE = 0.08838834764831845f;
constexpr float THR = 8.f;
constexpr int LDQ = PITCH;
#define KSWZ(row, colB) ((row) * 256 + ((colB) ^ (((row) & 7) << 4)))
#define SBAR() __builtin_amdgcn_sched_barrier(0)
__device__ __forceinline__ int v_st(int k, int c) { const int kk = (k & ~0xC) | ((k & 4) << 1) | ((k & 8) >> 1); return ((kk >> 3) * 4 + (c >> 5)) * 512 + ((kk & 7) * 32 + (c & 31)) * 2; }
__device__ __forceinline__ int v_rd_base(int lane) { return ((lane & 3) << 3) | (((lane >> 2) & 3) << 6) | (((lane >> 4) & 1) << 5) | (((lane >> 5) & 1) << 8); }
constexpr int v_rd_off(int d0, int ks, int half) { return d0 * 512 + ks * 4096 + half * 2048; }
__device__ __forceinline__ int crow(int r, int hi) { return (r & 3) + 8 * (r >> 2) + 4 * hi; }
__device__ __forceinline__ bf16x8 load8(const bf16_t* p) { return *reinterpret_cast<const bf16x8*>(p); }
__device__ __forceinline__ void mask_tile(f32x16& p0, f32x16& p1, int dq) {
    const float NEG = -__builtin_inff();
#pragma unroll
    for (int r = 0; r < 16; ++r) {
        const int c = (r & 3) + 8 * (r >> 2);
        if (dq - c < 0) p0[r] = NEG;
        if (dq - c - 32 < 0) p1[r] = NEG;
    }
}
__device__ __forceinline__ void bias_tile(f32x16& p0, f32x16& p1, const float* cb, float cq) {
#pragma unroll
    for (int j = 0; j < 4; ++j) { const f32x4 c0 = *(const f32x4*)(cb + 8 * j), c1 = *(const f32x4*)(cb + 8 * j + 32);
#pragma unroll
        for (int i = 0; i < 4; ++i) { p0[4 * j + i] = (p0[4 * j + i] + cq) - c0[i]; p1[4 * j + i] = (p1[4 * j + i] + cq) - c1[i]; }
        SBAR(); }
}
__device__ __forceinline__ void decay_tile(f32x16& p0, f32x16& p1, int dq, float lg2, float g1, float g2, float g3, float g32, bool needmask) {
    const float e0 = lg2 * (float)dq;
#pragma unroll
    for (int j = 0; j < 4; ++j) { const float f0 = __builtin_amdgcn_exp2f(fmaf(-lg2, (float)(8 * j), e0)), f1 = f0 * g1, f2 = f0 * g2, f3 = f0 * g3;
        p0[4 * j + 0] *= f0; p0[4 * j + 1] *= f1; p0[4 * j + 2] *= f2; p0[4 * j + 3] *= f3;
        p1[4 * j + 0] *= f0 * g32; p1[4 * j + 1] *= f1 * g32; p1[4 * j + 2] *= f2 * g32; p1[4 * j + 3] *= f3 * g32; }
    if (needmask) {
#pragma unroll
        for (int r = 0; r < 16; ++r) { const int c = (r & 3) + 8 * (r >> 2); if (dq - c < 0) p0[r] = 0.f; if (dq - c - 32 < 0) p1[r] = 0.f; }
    }
}
__device__ __forceinline__ void partialSM(f32x16& p0, f32x16& p1, float& m_reg, float& mn, float& alpha) {
    float pmax = p0[0];
#pragma unroll
    for (int r = 1; r < 16; ++r) pmax = fmaxf(pmax, p0[r]);
#pragma unroll
    for (int r = 0; r < 16; ++r) pmax = fmaxf(pmax, p1[r]);
    { auto rr = __builtin_amdgcn_permlane32_swap(__float_as_uint(pmax), __float_as_uint(pmax), false, false);
      pmax = fmaxf(__uint_as_float(rr[0]), __uint_as_float(rr[1])); }
    constexpr float C2 = 1.4426950408889634f * SCALE;
    if (__builtin_expect(__all((pmax - m_reg) * SCALE <= THR), 1)) { mn = m_reg; alpha = 1.f; }
    else { mn = fmaxf(m_reg, pmax); alpha = __builtin_amdgcn_exp2f((m_reg - mn) * C2); m_reg = mn; }
    const float mnL = -mn * C2;
#pragma unroll
    for (int r = 0; r < 16; ++r) p0[r] = fmaf(p0[r], C2, mnL);
#pragma unroll
    for (int r = 0; r < 16; ++r) p1[r] = fmaf(p1[r], C2, mnL);
#pragma unroll
    for (int r = 0; r < 16; ++r) p0[r] = __builtin_amdgcn_exp2f(p0[r]);
}
#define PK4(P, B_, OUT) do { unsigned a0 = cvtpk(P[B_+0], P[B_+1]), a1 = cvtpk(P[B_+2], P[B_+3]);                          \
        unsigned b0 = cvtpk(P[B_+4], P[B_+5]), b1 = cvtpk(P[B_+6], P[B_+7]);                                             \
        auto r0 = __builtin_amdgcn_permlane32_swap(a0, b0, false, false); auto r1 = __builtin_amdgcn_permlane32_swap(a1, b1, false, false); \
        u32x4 w = {r0[0], r1[0], r0[1], r1[1]}; OUT = *reinterpret_cast<bf16x8*>(&w); } while (0)
template <bool SOFTMAX>
__device__ __forceinline__ void finishSM(f32x16& p0, f32x16& p1, float alpha, float& l_reg, bf16x8& pa0, bf16x8& pa1, bf16x8& pa2, bf16x8& pa3) {
    if (SOFTMAX) {
#pragma unroll
        for (int r = 0; r < 16; ++r) p1[r] = __builtin_amdgcn_exp2f(p1[r]);
        float ps = 0;
#pragma unroll
        for (int r = 0; r < 16; ++r) ps += p0[r];
#pragma unroll
        for (int r = 0; r < 16; ++r) ps += p1[r];
        { auto rr = __builtin_amdgcn_permlane32_swap(__float_as_uint(ps), __float_as_uint(ps), false, false);
          ps = __uint_as_float(rr[0]) + __uint_as_float(rr[1]); }
        l_reg = l_reg * alpha + ps;
    }
    PK4(p0, 0, pa0); PK4(p0, 8, pa1); PK4(p1, 0, pa2); PK4(p1, 8, pa3);
}
#undef PK4
template <int KB, int NQF>
__device__ __forceinline__ void qkt(f32x16& p0, f32x16& p1, const char* K_lds, int r32, int hi, const bf16x8* qr) {
    p0 = f32x16{}; p1 = f32x16{};
    const char* kb[4];
#pragma unroll
    for (int dd = 0; dd < 4; ++dd) kb[dd] = K_lds + KB * SHM_K + KSWZ(r32, (dd * 16 + hi * 8) * 2);
#pragma unroll
    for (int d0 = 0; d0 < NQF; ++d0) { const char* a = kb[d0 & 3] + (d0 >> 2) * 128;
        bf16x8 b0 = *reinterpret_cast<const bf16x8*>(a);
        bf16x8 b1 = *reinterpret_cast<const bf16x8*>(a + 32 * 256);
        p0 = __builtin_amdgcn_mfma_f32_32x32x16_bf16(b0, qr[d0], p0, 0, 0, 0);
        p1 = __builtin_amdgcn_mfma_f32_32x32x16_bf16(b1, qr[d0], p1, 0, 0, 0); }
}
template <int VB>
__device__ __forceinline__ void pv_tile(f32x16* o, int vb0, bf16x8 pa0, bf16x8 pa1, bf16x8 pa2, bf16x8 pa3) {
#define TRRD(dst, off) asm volatile("ds_read_b64_tr_b16 %0, %1 offset:%2" : "=&v"(dst) : "v"(vb0), "i"(off) : "memory")
#define PV_D0(d0) do { s16x4 l0, l1, l2, l3, h0, h1, h2, h3; constexpr int b_ = VB * SHM_V + v_rd_off(d0, 0, 0); \
        TRRD(l0, b_); TRRD(h0, b_ + 2048); TRRD(l1, b_ + 4096); TRRD(h1, b_ + 6144); TRRD(l2, b_ + 8192); TRRD(h2, b_ + 10240); TRRD(l3, b_ + 12288); TRRD(h3, b_ + 14336); \
        asm volatile("s_waitcnt lgkmcnt(0)" ::: "memory"); SBAR();   \
        o[d0] = __builtin_amdgcn_mfma_f32_32x32x16_bf16(pa0, (bf16x8){l0[0], l0[1], l0[2], l0[3], h0[0], h0[1], h0[2], h0[3]}, o[d0], 0, 0, 0);   \
        o[d0] = __builtin_amdgcn_mfma_f32_32x32x16_bf16(pa1, (bf16x8){l1[0], l1[1], l1[2], l1[3], h1[0], h1[1], h1[2], h1[3]}, o[d0], 0, 0, 0);   \
        o[d0] = __builtin_amdgcn_mfma_f32_32x32x16_bf16(pa2, (bf16x8){l2[0], l2[1], l2[2], l2[3], h2[0], h2[1], h2[2], h2[3]}, o[d0], 0, 0, 0);   \
        o[d0] = __builtin_amdgcn_mfma_f32_32x32x16_bf16(pa3, (bf16x8){l3[0], l3[1], l3[2], l3[3], h3[0], h3[1], h3[2], h3[3]}, o[d0], 0, 0, 0); } while (0)
    PV_D0(0); PV_D0(1); PV_D0(2); PV_D0(3);
#undef PV_D0
#undef TRRD
}

struct BlockRef { unsigned q, k, v, o, z, cs; int P0; float lg2; };
struct Seam { bf16x8 qr[8]; bf16x8 st_v0, st_v1, st_k0, st_k1; };
#define GLD8(base, off) (*(const bf16x8*)((const char*)(base) + (off)))
#define VMW() asm volatile("s_waitcnt vmcnt(0)" ::: "memory")
#define VMWN(n) asm volatile("s_waitcnt vmcnt(%0)" :: "i"(n) : "memory")
#define SLOAD_H(Kp, Vp, k0) do { S.st_v0 = GLD8((Vp) + (size_t)(k0) * (LDKV * 2), kvoff); S.st_v1 = GLD8((Vp) + (size_t)((k0) + 32) * (LDKV * 2), kvoff);              \
                         if (sc < DQ) { S.st_k0 = GLD8((Kp) + (size_t)(k0) * (LDKV * 2), kvoff); S.st_k1 = GLD8((Kp) + (size_t)((k0) + 32) * (LDKV * 2), kvoff); } } while (0)
#define SWRITE_HK(bf) do { if (sc < DQ) { *(bf16x8*)(K_lds + (bf) * SHM_K + kws) = S.st_k0; *(bf16x8*)(K_lds + (bf) * SHM_K + kws + 32 * 256) = S.st_k1; } } while (0)
#define SWRITE_HV(bf) do { *(bf16x8*)(V_lds + (bf) * SHM_V + vst0) = S.st_v0; *(bf16x8*)(V_lds + (bf) * SHM_V + vst0 + 8192) = S.st_v1; } while (0)
#define SWRITE_H(bf) do { SWRITE_HV(bf); SWRITE_HK(bf); } while (0)
template <int MODE>
__device__ __forceinline__ void mix_prime(const BlockRef& cur, const char* wsb, char* lds, Seam& S) {
    constexpr int DQ = MODE == 2 ? 64 : 128, NQF = DQ / 16, LDKV = MODE == 1 ? 1024 : PITCH;
    const int tid = threadIdx.x, wid = __builtin_amdgcn_readfirstlane(tid >> 6), lane = tid & 63, r32 = lane & 31, hi = lane >> 5;
    const int sr = tid >> 4, sc = (tid & 15) * 8, kws = KSWZ(sr, sc * 2); char* K_lds = lds + 2 * SHM_V;
    const unsigned qoff = (unsigned)(((wid * QBLK + r32) * LDQ + hi * 8) * 2), kvoff = (unsigned)((sr * LDKV + sc) * 2);
#pragma unroll
    for (int d0 = 0; d0 < NQF; ++d0) S.qr[d0] = GLD8(wsb + cur.q + d0 * 32, qoff);
    SLOAD_H(wsb + cur.k, wsb + cur.v, 0);
    if (MODE == 0) { const f32x4 c = *(const f32x4*)(wsb + cur.cs + tid * 16); *(f32x4*)((float*)(lds + OFF_CS) + tid * 4) = c; }
    VMW(); SWRITE_HK(0);
    __syncthreads();
}
template <int MODE>
__device__ __forceinline__ void mix_block(const BlockRef& cur, const BlockRef& nxt, const char* wsb, char* lds, Seam& S, int par) {
    constexpr int DQ = MODE == 2 ? 64 : 128, NQF = DQ / 16, LDKV = MODE == 1 ? 1024 : PITCH; constexpr bool CAUSAL = MODE != 1, SOFTMAX = MODE != 2;
    const int tid = threadIdx.x, wid = __builtin_amdgcn_readfirstlane(tid >> 6), lane = tid & 63, r32 = lane & 31, hi = lane >> 5;
    const int NT = CAUSAL ? cur.P0 / KVBLK + 4 : NMEM / KVBLK;
    const int qlo = cur.P0 + wid * QBLK, qm = qlo + r32 - 4 * hi;
    char* V_lds = lds; char* K_lds = lds + 2 * SHM_V;
    float* ws = (float*)(lds + OFF_WS) + wid * 64; float* li_l = ws, * al_l = ws + 32;
    const float* cs_cur = (const float*)(lds + OFF_CS) + par * SEQ; float* cs_nxt = (float*)(lds + OFF_CS) + (par ^ 1) * SEQ;
    float m_reg = -1e30f, l_reg = 0; f32x16 o[4] = {};
    const int sr = tid >> 4, sc = (tid & 15) * 8, vst0 = v_st(sr, sc), kws = KSWZ(sr, sc * 2);
    const int vb0 = (int)(uintptr_t)V_lds + v_rd_base(lane);
    const char* Kh = wsb + cur.k; const char* Vh = wsb + cur.v;
    const unsigned qoff = (unsigned)(((wid * QBLK + r32) * LDQ + hi * 8) * 2), kvoff = (unsigned)((sr * LDKV + sc) * 2), eoff = (unsigned)(((wid * QBLK + 4 * hi) * LDQ + r32) * 2);
    const float lg2 = cur.lg2;
    float g1 = 1.f, g2 = 1.f, g3 = 1.f, g32 = 1.f;
    if (MODE == 2) { g1 = __uint_as_float(__builtin_amdgcn_readfirstlane(__float_as_uint(__builtin_amdgcn_exp2f(-lg2)))); g2 = g1 * g1; g3 = g2 * g1;
        g32 = __uint_as_float(__builtin_amdgcn_readfirstlane(__float_as_uint(__builtin_amdgcn_exp2f(-32.f * lg2)))); }
#define RESC(a) do { if (SOFTMAX) { if (__any((a) < 1.f)) { if (hi == 0) al_l[r32] = (a); asm volatile("s_waitcnt lgkmcnt(0)" ::: "memory");              \
                     for (int d_ = 0; d_ < 4; ++d_) for (int r = 0; r < 16; ++r) o[d_][r] *= al_l[crow(r, hi)]; } } } while (0)
#define KBASE(t) ((t) * KVBLK)
#define SCORE_FIX(P0_, P1_, mnX, alX, t) do { const int kb_ = KBASE(t);                                                                    \
        if (MODE == 0) { bias_tile(P0_, P1_, cs_cur + kb_ + 4 * hi, cs_cur[qlo + r32]); }                                                      \
        if (MODE == 2) { decay_tile(P0_, P1_, qm - kb_, lg2, g1, g2, g3, g32, kb_ + KVBLK - 1 > qlo); }                            \
        else { if (CAUSAL && (kb_ + KVBLK - 1 > qlo)) mask_tile(P0_, P1_, qm - kb_); partialSM(P0_, P1_, m_reg, mnX, alX); } } while (0)
#define SEAM_K0() do { VMWN(NQF); SWRITE_HK(0); SBAR(); if (MODE == 0) { const f32x4 c_ = *(const f32x4*)(wsb + nxt.cs + tid * 16); *(f32x4*)(cs_nxt + tid * 4) = c_; } SBAR(); } while (0)
    f32x16 pA0, pA1, pB0, pB1; float mnA = 0, mnB = 0, alA = 1.f, alB = 1.f; bf16x8 pa0, pa1, pa2, pa3;
    SWRITE_HV(0); SBAR();
    if (NT > 1) { SLOAD_H(Kh, Vh, KBASE(1)); }
    SBAR(); qkt<0, NQF>(pA0, pA1, K_lds, r32, hi, S.qr);
    SCORE_FIX(pA0, pA1, mnA, alA, 0);
    if (NT > 1) { VMW(); SWRITE_H(1); }
    __syncthreads();
#define HALF_STEP(PX0, PX1, mnX, alX, PY0, PY1, alY, t, KB, VB, SB) do {                                                      \
        SBAR(); qkt<KB, NQF>(PX0, PX1, K_lds, r32, hi, S.qr);                                                                 \
        finishSM<SOFTMAX>(PY0, PY1, alY, l_reg, pa0, pa1, pa2, pa3); SBAR();                                                  \
        if ((t) + 1 < NT) { SLOAD_H(Kh, Vh, KBASE((t) + 1)); SBAR(); }                                                  \
        pv_tile<VB>(o, vb0, pa0, pa1, pa2, pa3); SCORE_FIX(PX0, PX1, mnX, alX, (t));                                          \
        __syncthreads();                                                                                                      \
        if ((t) + 1 < NT) { VMW(); SWRITE_H(SB); }                                                                            \
        RESC(alX); __syncthreads(); } while (0)
    for (int t = 1; t + 1 < NT; t += 2) {
        HALF_STEP(pB0, pB1, mnB, alB, pA0, pA1, alA, t, 1, 0, 0);
        HALF_STEP(pA0, pA1, mnA, alA, pB0, pB1, alB, t + 1, 0, 1, 1);
    }
    const bool even = (NT & 1) == 0;
    if (even) { SBAR(); qkt<1, NQF>(pB0, pB1, K_lds, r32, hi, S.qr); SBAR(); }
    SLOAD_H(wsb + nxt.k, wsb + nxt.v, 0);
    SBAR();
#pragma unroll
    for (int d0 = 0; d0 < NQF; ++d0) S.qr[d0] = GLD8(wsb + nxt.q + d0 * 32, qoff);
    SBAR();
    finishSM<SOFTMAX>(pA0, pA1, alA, l_reg, pa0, pa1, pa2, pa3); SBAR();
    pv_tile<0>(o, vb0, pa0, pa1, pa2, pa3);
    if (even) { SCORE_FIX(pB0, pB1, mnB, alB, NT - 1); __syncthreads(); RESC(alB);
        finishSM<SOFTMAX>(pB0, pB1, alB, l_reg, pa0, pa1, pa2, pa3); SBAR(); pv_tile<1>(o, vb0, pa0, pa1, pa2, pa3); }
    SBAR(); SEAM_K0();
    {
        float* stg = (float*)(lds + OFF_STG) + wid * (16 * STG_LD);
        if (SOFTMAX) { if (hi == 0) li_l[r32] = l_reg; }
        const int lr4 = lane >> 4, c8 = (lane & 15) * 8;
        const unsigned e2 = (unsigned)(((wid * QBLK + lr4) * LDQ + c8) * 2);
#pragma unroll
        for (int p = 0; p < 2; ++p) {
#pragma unroll
            for (int rr = 0; rr < 8; ++rr) { const int lr = (rr & 3) + 8 * (rr >> 2) + 4 * hi;
#pragma unroll
                for (int d0 = 0; d0 < 4; ++d0) stg[lr * STG_LD + d0 * 32 + r32] = o[d0][8 * p + rr]; }
            u32x4 zz[4];
#pragma unroll
            for (int i = 0; i < 4; ++i) zz[i] = *(const u32x4*)(wsb + cur.z + (size_t)(16 * p + 4 * i) * (LDQ * 2) + e2);
#pragma unroll
            for (int i = 0; i < 4; ++i) { const int lr = lr4 + 4 * i;
                const f32x4 a = *(const f32x4*)(stg + lr * STG_LD + c8), b = *(const f32x4*)(stg + lr * STG_LD + c8 + 4);
                float rn;
                if (SOFTMAX) rn = __builtin_amdgcn_rcpf(li_l[16 * p + lr]);
                else { float ss = (a[0] * a[0] + a[1] * a[1]) + (a[2] * a[2] + a[3] * a[3]) + (b[0] * b[0] + b[1] * b[1]) + (b[2] * b[2] + b[3] * b[3]);
                    ss = dpp_xadd<0xB1>(ss); ss = dpp_xadd<0x4E>(ss); ss = dpp_xadd<0x141>(ss); ss = dpp_xadd<0x140>(ss);
                    rn = __builtin_amdgcn_rsqf(ss * (1.0f / 128.0f) + EPS); }
                u32x4 w;
                w.x = cvtpk(a[0] * rn * silu_f(__uint_as_float(zz[i].x << 16)), a[1] * rn * silu_f(__uint_as_float(zz[i].x & 0xffff0000u)));
                w.y = cvtpk(a[2] * rn * silu_f(__uint_as_float(zz[i].y << 16)), a[3] * rn * silu_f(__uint_as_float(zz[i].y & 0xffff0000u)));
                w.z = cvtpk(b[0] * rn * silu_f(__uint_as_float(zz[i].z << 16)), b[1] * rn * silu_f(__uint_as_float(zz[i].z & 0xffff0000u)));
                w.w = cvtpk(b[2] * rn * silu_f(__uint_as_float(zz[i].w << 16)), b[3] * rn * silu_f(__uint_as_float(zz[i].w & 0xffff0000u)));
                *(u32x4*)((char*)wsb + cur.o + (size_t)(16 * p + 4 * i) * (LDQ * 2) + e2) = w; }
        }
    }
    __syncthreads();
#undef RESC
#undef KBASE
#undef SCORE_FIX
#undef SEAM_K0
#undef HALF_STEP
}
#undef GLD8
#undef VMW
#undef VMWN
#undef SLOAD_H
#undef SWRITE_HK
#undef SWRITE_HV
#undef SWRITE_H
}


#define XB_TMO      128
#define XB_XCNT(j)  (256  + 64 * (j))
#define XB_XSUB(j)  (1280 + 64 * (j))
#define XB_XGEN(j)  (2304 + 64 * (j))
#define XB_TOP      3328
#define XB_TOPGEN   3392
#define XCD_BAR_WORDS 3456
#define XB_SPIN_CAP (1u << 18)
#define LAS __attribute__((address_space(3)))
__device__ __forceinline__ unsigned xb_ld(unsigned* p)              { return __hip_atomic_load(p, __ATOMIC_RELAXED, __HIP_MEMORY_SCOPE_AGENT); }
__device__ __forceinline__ unsigned xb_add(unsigned* p, unsigned v) { return __hip_atomic_fetch_add(p, v, __ATOMIC_RELAXED, __HIP_MEMORY_SCOPE_AGENT); }
__device__ __forceinline__ unsigned xb_xcc_id() { return (unsigned)__builtin_amdgcn_s_getreg((3 << 11) | 20) & 0xFu; }
#define XB_SPIN(cond, bar) do { unsigned _sp = 0; while (cond) { __builtin_amdgcn_s_sleep(1); \
    if ((++_sp & 255u) == 0u) { if (xb_ld(&(bar)[XB_TMO])) break; if (_sp > XB_SPIN_CAP) { atomicAdd(&(bar)[XB_TMO], 1u); break; } } } } while (0)
struct XcdBarrier { unsigned* bar; unsigned x; volatile LAS unsigned* st; };
__device__ __forceinline__ XcdBarrier xcd_barrier_post(unsigned* bar, volatile LAS unsigned* st) {
    XcdBarrier b; b.bar = bar; b.x = xb_xcc_id(); b.st = st;
    if (threadIdx.x == 0) (void)xb_add(&bar[XB_XCNT(b.x)], 1u);
    return b;
}
__device__ __forceinline__ void xcd_barrier_complete(unsigned* bar, unsigned x, unsigned& nloc, unsigned& nx) {
    const unsigned G = gridDim.x * gridDim.y * gridDim.z;
    unsigned sum, cnt, mine, sp = 0u;
    for (;;) {
        sum = 0u; cnt = 0u; mine = 0u;
#pragma unroll
        for (unsigned j = 0; j < 16; ++j) { const unsigned c = xb_ld(&bar[XB_XCNT(j)]); sum += c; cnt += (c > 0u) ? 1u : 0u; mine = (j == x) ? c : mine; }
        if (sum == G) break;
        __builtin_amdgcn_s_sleep(1);
        if ((++sp & 255u) == 0u) { if (xb_ld(&bar[XB_TMO])) break; if (sp > XB_SPIN_CAP) { atomicAdd(&bar[XB_TMO], 1u); break; } }
    }
    nloc = mine > 0u ? mine : 1u; nx = cnt > 0u ? cnt : 1u;
}
__device__ __forceinline__ void xcd_barrier(const XcdBarrier& b) {
    asm volatile("s_waitcnt vmcnt(0)" ::: "memory");
    __syncthreads();
    if (threadIdx.x == 0) {
        unsigned* bar = b.bar;
        __builtin_amdgcn_s_waitcnt(0);
        unsigned nloc = b.st[0], nx = b.st[1];
        if (nloc == 0u) { xcd_barrier_complete(bar, b.x, nloc, nx); b.st[0] = nloc; b.st[1] = nx; }
        const unsigned old = xb_add(&bar[XB_XSUB(b.x)], 1u);
        const unsigned gen = old / nloc;
        if (old + 1u == (gen + 1u) * nloc) {
            __builtin_amdgcn_fence(__ATOMIC_RELEASE, "agent");
            asm volatile("s_waitcnt vmcnt(0)" ::: "memory");
            const unsigned og = xb_add(&bar[XB_TOP], 1u);
            const unsigned tg = og / nx;
            if (og + 1u == (tg + 1u) * nx) xb_add(&bar[XB_TOPGEN], 1u);
            else XB_SPIN(xb_ld(&bar[XB_TOPGEN]) == tg, bar);
            __builtin_amdgcn_fence(__ATOMIC_ACQUIRE, "agent");
            xb_add(&bar[XB_XGEN(b.x)], 1u);
            asm volatile("s_waitcnt vmcnt(0)" ::: "memory");
        } else {
            XB_SPIN(xb_ld(&bar[XB_XGEN(b.x)]) == gen, bar);
            __builtin_amdgcn_fence(__ATOMIC_ACQUIRE, "agent");
            asm volatile("s_waitcnt vmcnt(0)" ::: "memory");
        }
    }
    __syncthreads();
}
constexpr int NTHR = 512;
constexpr int LDS_BYTES = att::LDS_BYTES + 128;
static_assert(LDS_BYTES >= 131072 + 128 && LDS_BYTES <= 160 * 1024, "LDS budget");
struct Args { const float* in[10]; float* out; unsigned char* ws; int ph_lo, ph_hi; };

__device__ __forceinline__ float wave_sum(float v) {
    v = dpp_xadd<0xB1>(v); v = dpp_xadd<0x4E>(v); v = dpp_xadd<0x141>(v); v = dpp_xadd<0x140>(v);
    { auto r = __builtin_amdgcn_permlane16_swap(__float_as_uint(v), __float_as_uint(v), false, false); v = __uint_as_float(r[0]) + __uint_as_float(r[1]); }
    { auto r = __builtin_amdgcn_permlane32_swap(__float_as_uint(v), __float_as_uint(v), false, false); v = __uint_as_float(r[0]) + __uint_as_float(r[1]); }
    return v;
}
__device__ __forceinline__ void load_row(const float* xr, int lane, f32x4 (&y)[4]) {
#pragma unroll
    for (int i = 0; i < 4; ++i) y[i] = *(const f32x4*)(xr + 256 * i + 4 * lane);
}
__device__ __forceinline__ void rms_row(const float* g, bf16_t* outr, int lane, f32x4 (&y)[4]) {
    float ss = 0.f;
#pragma unroll
    for (int i = 0; i < 4; ++i) ss += y[i][0] * y[i][0] + y[i][1] * y[i][1] + y[i][2] * y[i][2] + y[i][3] * y[i][3];
    ss = wave_sum(ss);
    const float rs = 1.0f / sqrtf(ss * (1.0f / 1024.0f) + EPS);
#pragma unroll
    for (int i = 0; i < 4; ++i) { const f32x4 gg = *(const f32x4*)(g + 256 * i + 4 * lane); y[i] = y[i] * rs * gg;
        u32x2 w; w.x = cvtpk(y[i][0], y[i][1]); w.y = cvtpk(y[i][2], y[i][3]); *(u32x2*)(outr + 256 * i + 4 * lane) = w; }
}
template <class Map>
__device__ __forceinline__ void transpose_tiles(const float* W, int ldw, int K, int N, bf16_t* Wt, float* tile, int& tcount, int G, int c, const Map& srcmap) {
    const int tid = threadIdx.x; const int ntk = K / 128, ntn = N / 64;
    for (int t = 0; t < ntk * ntn; ++t, ++tcount) {
        if (tcount % G != c) continue;
        const int k0 = (t % ntk) * 128, n0 = (t / ntk) * 64;
        float v[16];
        { const int n = tid & 63, kk = tid >> 6; const int sn = srcmap(n0 + n);
#pragma unroll
          for (int i = 0; i < 16; ++i) v[i] = W[(size_t)(k0 + kk + 8 * i) * ldw + sn];
          __syncthreads();
#pragma unroll
          for (int i = 0; i < 16; ++i) tile[(kk + 8 * i) * 65 + n] = v[i]; }
        __syncthreads();
        { const int k = (tid & 63) * 2, nn = tid >> 6;
#pragma unroll
          for (int i = 0; i < 8; ++i) { const int n = nn + 8 * i; *(unsigned*)(Wt + (size_t)(n0 + n) * K + k0 + k) = cvtpk(tile[k * 65 + n], tile[(k + 1) * 65 + n]); } }
    }
}
struct MapL0 { __device__ int operator()(int n) const { return n < 4608 ? n : n + 12; } };
struct MapL1 { __device__ int operator()(int n) const { if (n >= 1536) return n; const int p = n & 63; return (n & ~63) + (p & 1) * 32 + (p >> 1); } };
struct MapId { __device__ int operator()(int n) const { return n; } };

__device__ __constant__ const unsigned char DEAL_MAIN[8][8] = {
    { 0 * 8 + 7, 0 * 8 + 5, 0xFF, 0xFF, 0xFF, 0xFF, 0xFF, 0xFF }, { 1 * 8 + 7, 1 * 8 + 5, 0xFF, 0xFF, 0xFF, 0xFF, 0xFF, 0xFF }, { 2 * 8 + 7, 2 * 8 + 5, 0xFF, 0xFF, 0xFF, 0xFF, 0xFF, 0xFF },
    { 0 * 8 + 6, 0 * 8 + 4, 0 * 8 + 1, 0xFF, 0xFF, 0xFF, 0xFF, 0xFF }, { 1 * 8 + 6, 1 * 8 + 4, 1 * 8 + 1, 0xFF, 0xFF, 0xFF, 0xFF, 0xFF }, { 2 * 8 + 6, 2 * 8 + 4, 2 * 8 + 1, 0xFF, 0xFF, 0xFF, 0xFF, 0xFF },
    { 0 * 8 + 3, 1 * 8 + 3, 0 * 8 + 2, 1 * 8 + 2, 0xFF, 0xFF, 0xFF, 0xFF }, { 2 * 8 + 3, 2 * 8 + 2, 0 * 8 + 0, 1 * 8 + 0, 2 * 8 + 0, 0xFF, 0xFF, 0xFF } };
__device__ __constant__ const unsigned char DEAL_MEM_N[8] = { 1, 1, 1, 1, 1, 1, 0, 2 };
__device__ __constant__ const unsigned char DEAL_MEM_S[8] = { 0, 1, 2, 3, 4, 5, 6, 6 };
template <int MODE>
__device__ __forceinline__ bool get_block(int layer, int G, int c, int k, att::BlockRef& r) {
    const bool tab = (G == 256); const int vcu = (c & 7) * 32 + (c >> 3), grp = vcu >> 3, slot = vcu & 7;
    if (MODE == 1) {
        int L;
        if (tab) { if (k >= DEAL_MEM_N[slot]) return false; L = grp * 8 + DEAL_MEM_S[slot] + k; }
        else { L = c + k * G; if (L >= NB * NHM * 8) return false; }
        const int qb = L & 7, hm = (L >> 3) & 3, b = L >> 5;
        const int qcol = (layer == 0 ? L0_QM : L1_QM) + hm * 128, zcol = (layer == 0 ? L0_Z : L1_Z) + MAIN_W + hm * 128;
        const unsigned rowoff = (unsigned)WS_PROJ + (unsigned)(b * SEQ + qb * 256) * (unsigned)(PITCH * 2);
        const unsigned kv = (unsigned)WS_KVM + (unsigned)(b * NMEM) * 2048u + hm * 256;
        r.q = rowoff + qcol * 2; r.o = r.q; r.z = rowoff + zcol * 2; r.k = kv; r.v = kv + 1024; r.cs = 0; r.P0 = 0; r.lg2 = 0.f;
        return true;
    } else {
        int bh, qb;
        if (tab) { if (k >= 8) return false; const unsigned e = DEAL_MAIN[slot][k]; if (e == 0xFFu) return false; bh = grp * 3 + (int)(e >> 3); qb = (int)(e & 7u); }
        else { const int item = c + (k >> 1) * G; if (item >= NB * NH * 4) return false; const int x = item & 3; bh = item >> 2; qb = (k & 1) ? 7 - x : x; }
        const int b = bh / NH, h = bh % NH;
        const unsigned rowb = (unsigned)WS_PROJ + (unsigned)(b * SEQ) * (unsigned)(PITCH * 2), row0 = rowb + (unsigned)(qb * 256) * (unsigned)(PITCH * 2);
        if (MODE == 0) {
            r.q = row0 + (L0_Q + h * 128) * 2; r.o = r.q; r.z = row0 + (L0_Z + h * 128) * 2;
            r.k = rowb + (L0_K + h * 128) * 2; r.v = rowb + (L0_V + h * 128) * 2;
            r.cs = (unsigned)WS_CS + (unsigned)bh * (SEQ * 4); r.lg2 = 0.f;
        } else {
            r.q = row0 + (L1_Q + h * 64) * 2; r.o = row0 + (L1_H + h * 128) * 2; r.z = row0 + (L1_Z + h * 128) * 2;
            r.k = rowb + (L1_K + h * 64) * 2; r.v = rowb + (L1_V + h * 128) * 2;
            r.cs = 0; r.lg2 = __uint_as_float(__builtin_amdgcn_readfirstlane(__float_as_uint(log1pf(-exp2f(-5.0f - (float)h)) * 1.4426950408889634f)));
        }
        r.P0 = qb * 256;
        return true;
    }
}
template <int MODE>
__device__ __forceinline__ void run_stream(int layer, int G, int c, const char* wsb, char* lds) {
    att::BlockRef cur, nxt; int k = 0;
    if (!get_block<MODE>(layer, G, c, 0, cur)) return;
    att::Seam S; int par = 0;
    att::mix_prime<MODE>(cur, wsb, lds, S);
    for (;;) {
        const bool has = get_block<MODE>(layer, G, c, k + 1, nxt);
        if (!has) nxt = cur;
        att::mix_block<MODE>(cur, nxt, wsb, lds, S, par);
        if (!has) break;
        cur = nxt; ++k; par ^= 1;
    }
}
__device__ __forceinline__ void p0_body(unsigned char* lds, int tid, int lane, int wid, int G, int c, const float* x, const float* mem, const float* norm_g, const float* fox_w_in,
                                        const float* fox_b_f, const float* mem_norm_g, const float* w_mem_kv, const float* w_out, bf16_t* h0, float* cs, bf16_t* memn, float* rot,
                                        bf16_t* Wt_in, bf16_t* Wt_kv, bf16_t* Wt_out) {
        float* Wf = (float*)lds;
        float* tile = (float*)(lds + 49152);
        for (int i = tid; i < 3 * 1024; i += NTHR) { const int k = i / 3, q = i % 3; const f32x4 w = *(const f32x4*)(fox_w_in + (size_t)k * FOX_IN + 4608 + 4 * q);
            Wf[(4 * q + 0) * 1024 + k] = w[0]; Wf[(4 * q + 1) * 1024 + k] = w[1]; Wf[(4 * q + 2) * 1024 + k] = w[2]; Wf[(4 * q + 3) * 1024 + k] = w[3]; }
        __syncthreads();
        { int row = c * 8 + wid; f32x4 nx[4];
          if (row < MROWS) load_row(x + (size_t)row * DM, lane, nx);
          for (; row < MROWS; row += G * 8) {
            f32x4 y[4];
#pragma unroll
            for (int i = 0; i < 4; ++i) y[i] = nx[i];
            if (row + G * 8 < MROWS) load_row(x + (size_t)(row + G * 8) * DM, lane, nx);
            rms_row(norm_g, h0 + (size_t)row * DM, lane, y);
            float myv = 0.f;
#pragma unroll
            for (int j = 0; j < 12; ++j) { float a = 0.f;
#pragma unroll
                for (int i = 0; i < 4; ++i) { const f32x4 w = *(const f32x4*)(Wf + j * 1024 + 256 * i + 4 * lane); a += y[i][0] * w[0] + y[i][1] * w[1] + y[i][2] * w[2] + y[i][3] * w[3]; }
                a = wave_sum(a); if (lane == j) myv = a; }
            if (lane < 12) { const float t = myv + fox_b_f[lane];
                const float ls = t >= 0.f ? -log1pf(expf(-t)) : t - log1pf(expf(t));
                const int b = row / SEQ, s = row % SEQ; cs[((size_t)b * NH + lane) * SEQ + s] = ls; }
          } }
        for (int row = c * 8 + wid; row < NB * NMEM; row += G * 8) { f32x4 y[4]; load_row(mem + (size_t)row * DM, lane, y); rms_row(mem_norm_g, memn + (size_t)row * DM, lane, y); }
        for (int i = c * NTHR + tid; i < SEQ * 32; i += G * NTHR) { const int pos = i >> 5, j = i & 31;
            const float inv = 1.0f / powf(10000.0f, (float)j / 32.0f); const float ang = (float)pos * inv;
            rot[2 * i] = cosf(ang); rot[2 * i + 1] = sinf(ang); }
        int tc = 0;
        transpose_tiles(fox_w_in, FOX_IN, DM, NPROJ0, Wt_in, tile, tc, G, c, MapL0());
        transpose_tiles(w_mem_kv, 1024, DM, 1024, Wt_kv, tile, tc, G, c, MapId());
        transpose_tiles(w_out, DM, INNER, DM, Wt_out, tile, tc, G, c, MapId());
        __syncthreads();
}
__device__ __forceinline__ void p4_body(unsigned char* lds, int tid, int lane, int wid, int G, int c, const float* out, const float* norm_g, const float* ret_w_in, const float* w_mem_kv,
                                        const float* w_out, bf16_t* proj, bf16_t* Wt_in, bf16_t* Wt_kv, bf16_t* Wt_out) {
        float* tile = (float*)(lds + 49152);
        { int row = c * 8 + wid; f32x4 nx[4];
          if (row < MROWS) load_row(out + (size_t)row * DM, lane, nx);
          for (; row < MROWS; row += G * 8) {
            f32x4 y[4];
#pragma unroll
            for (int i = 0; i < 4; ++i) y[i] = nx[i];
            if (row + G * 8 < MROWS) load_row(out + (size_t)(row + G * 8) * DM, lane, nx);
            rms_row(norm_g + DM, proj + (size_t)row * PITCH + L1_H, lane, y);
          } }
        int tc = 0;
        transpose_tiles(ret_w_in, RET_IN, DM, NPROJ1, Wt_in, tile, tc, G, c, MapL1());
        transpose_tiles(w_mem_kv + (size_t)DM * 1024, 1024, DM, 1024, Wt_kv, tile, tc, G, c, MapId());
        transpose_tiles(w_out + (size_t)INNER * DM, DM, INNER, DM, Wt_out, tile, tc, G, c, MapId());
        __syncthreads();
}
__global__ void __launch_bounds__(NTHR, 2) mk_fwd(Args args) {
    extern __shared__ __attribute__((aligned(16))) unsigned char lds[];
    const int tid = threadIdx.x, lane = tid & 63, wid = __builtin_amdgcn_readfirstlane(tid >> 6);
    const int G = gridDim.x, c = blockIdx.x;
    typedef const __attribute__((address_space(4))) Args* KArgP;
    KArgP ap = (KArgP)__builtin_amdgcn_kernarg_segment_ptr();
#define PH_ARGS asm volatile("" : "+s"(ap)); unsigned char* ws = ap->ws; float* out = ap->out;                                                           \
    const float* x = ap->in[0]; const float* mem = ap->in[1]; const float* norm_g = ap->in[2]; const float* fox_w_in = ap->in[3]; const float* fox_b_f = ap->in[4]; \
    const float* ret_w_in = ap->in[5]; const float* mem_norm_g = ap->in[6]; const float* w_mem_kv = ap->in[7]; const float* w_out = ap->in[8]; const float* final_g = ap->in[9]; \
    bf16_t* Wt_in = (bf16_t*)(ws + WS_WIN); bf16_t* Wt_kv = (bf16_t*)(ws + WS_WKV); bf16_t* Wt_out = (bf16_t*)(ws + WS_WOUT);                              \
    bf16_t* proj = (bf16_t*)(ws + WS_PROJ); bf16_t* memn = (bf16_t*)(ws + WS_MEMN); bf16_t* kvm = (bf16_t*)(ws + WS_KVM);                                   \
    float* cs = (float*)(ws + WS_CS); float* rot = (float*)(ws + WS_ROT); bf16_t* h0 = (bf16_t*)out;                                                       \
    (void)x; (void)mem; (void)norm_g; (void)fox_w_in; (void)fox_b_f; (void)ret_w_in; (void)mem_norm_g; (void)w_mem_kv; (void)w_out; (void)final_g;       \
    (void)Wt_in; (void)Wt_kv; (void)Wt_out; (void)proj; (void)memn; (void)kvm; (void)cs; (void)rot; (void)h0
    const int lo = ap->ph_lo, hi_ = ap->ph_hi;
#ifndef PROBE_PHASE
#define PROBE_PHASE -1
#endif
#if PROBE_PHASE >= 0
#define REPS(k) for (int rep_ = 0; rep_ < ((k) == PROBE_PHASE ? 2 : 1); ++rep_)
#define DRY false
#else
#define REPS(k)
#define DRY false
#endif
#ifndef PH_MASK
#define PH_MASK 0x1ff
#endif
#define IN(k) (((PH_MASK >> (k)) & 1) && lo <= (k) && (k) < hi_)
    volatile LAS unsigned* bst = (volatile LAS unsigned*)((LAS unsigned char*)lds + (LDS_BYTES - 16));
    if (tid < 4) bst[tid] = 0u;
    __syncthreads();
    XcdBarrier xbar; xbar.bar = (unsigned*)(ap->ws + WS_CTL); xbar.x = 0; xbar.st = bst;
    if (IN(0) && IN(2)) xbar = xcd_barrier_post((unsigned*)(ap->ws + WS_CTL), bst);
#define SEAM(k) do { if (IN(k) && IN((k) + 1)) { if ((k) == 0) { cg::this_grid().sync(); } else { xcd_barrier(xbar); } } } while (0)

    if (IN(0)) { PH_ARGS;
        p0_body(lds, tid, lane, wid, G, c, x, mem, norm_g, fox_w_in, fox_b_f, mem_norm_g, w_mem_kv, w_out, h0, cs, memn, rot, Wt_in, Wt_kv, Wt_out);
        if (PROBE_PHASE == 0) p0_body(lds, tid, lane, wid, G, c, x, mem, norm_g, fox_w_in, fox_b_f, mem_norm_g, w_mem_kv, w_out, h0, cs, memn, rot, Wt_in, Wt_kv, Wt_out);
    }
    SEAM(0);
    if (IN(1)) { PH_ARGS;
        float* wt = (float*)lds;
        for (int seq = c; seq < NB * NH; seq += G) {
            float* p = cs + (size_t)seq * SEQ + tid * 4; f32x4 v = *(const f32x4*)p;
            v[1] += v[0]; v[2] += v[1]; v[3] += v[2];
            float tot = v[3], inc = tot;
#pragma unroll
            for (int d = 1; d < 64; d <<= 1) { const float n = __shfl_up(inc, d); if (lane >= d) inc += n; }
            __syncthreads();
            if (lane == 63) wt[wid] = inc;
            __syncthreads();
            float base = inc - tot; for (int w = 0; w < wid; ++w) base += wt[w];
            v = (v + base) * SQRT_HD; *(f32x4*)p = v;
        }
        __syncthreads();
        { pg8::Gemm g{h0, Wt_in, MROWS, NPROJ0, DM, DM, DM, 1 << 30, 0}; pg8::StaticOrder S; S.init(MROWS, NPROJ0, G, c, PROBE_PHASE == 1 ? 2 : 1);
          pg8::EpiBf16 E{proj, PITCH}; pg8::gemm_phase<pg8::EpiBf16, pg8::StaticOrder>((PG8_LAS unsigned char*)lds, g, S, E); }
        { pg8::Gemm g{memn, Wt_kv, NB * NMEM, 1024, DM, DM, DM, 1 << 30, 0}; pg8::StaticOrder S; S.init(NB * NMEM, 1024, G, c);
          pg8::EpiBf16 E{kvm, 1024}; pg8::gemm_phase<pg8::EpiBf16, pg8::StaticOrder>((PG8_LAS unsigned char*)lds, g, S, E); }
    }
    SEAM(1);
    if (IN(2)) { PH_ARGS;
#ifndef NO_M0
        run_stream<0>(0, G, c, (const char*)ws, (char*)lds);
#endif
#ifndef NO_M1
        run_stream<1>(0, G, c, (const char*)ws, (char*)lds);
#endif
    }
    SEAM(2);
    if (IN(3)) { PH_ARGS;
        pg8::Gemm g{proj + L0_Q, Wt_out, MROWS, DM, INNER, PITCH, INNER, MAIN_W / 64, (L0_QM - MAIN_W) * 2}; pg8::StaticOrder S; S.init(MROWS, DM, G, c, PROBE_PHASE == 3 ? 2 : 1);
        pg8::EpiRes E{x, out, DM}; pg8::gemm_phase<pg8::EpiRes, pg8::StaticOrder>((PG8_LAS unsigned char*)lds, g, S, E);
    }
    SEAM(3);
    if (IN(4)) { PH_ARGS;
        p4_body(lds, tid, lane, wid, G, c, out, norm_g, ret_w_in, w_mem_kv, w_out, proj, Wt_in, Wt_kv, Wt_out);
        if (PROBE_PHASE == 4) p4_body(lds, tid, lane, wid, G, c, out, norm_g, ret_w_in, w_mem_kv, w_out, proj, Wt_in, Wt_kv, Wt_out);
    }
    SEAM(4);
    if (IN(5)) { PH_ARGS;
        { pg8::Gemm g{proj + L1_H, Wt_in, MROWS, NPROJ1, DM, PITCH, DM, 1 << 30, 0}; pg8::StaticOrder S; S.init(MROWS, NPROJ1, G, c, PROBE_PHASE == 5 ? 2 : 1);
          pg8::EpiRot E{proj, PITCH, rot}; pg8::gemm_phase<pg8::EpiRot, pg8::StaticOrder>((PG8_LAS unsigned char*)lds, g, S, E); }
        { pg8::Gemm g{memn, Wt_kv, NB * NMEM, 1024, DM, DM, DM, 1 << 30, 0}; pg8::StaticOrder S; S.init(NB * NMEM, 1024, G, (c + G / 2) % G);
          pg8::EpiBf16 E{kvm, 1024}; pg8::gemm_phase<pg8::EpiBf16, pg8::StaticOrder>((PG8_LAS unsigned char*)lds, g, S, E); }
    }
    SEAM(5);
    if (IN(6)) { PH_ARGS;
#ifndef NO_M2
        if (PROBE_PHASE == 6) run_stream<2>(1, G, c, (const char*)ws, (char*)lds);
        run_stream<2>(1, G, c, (const char*)ws, (char*)lds);
#endif
#ifndef NO_M1
        run_stream<1>(1, G, c, (const char*)ws, (char*)lds);
#endif
    }
    SEAM(6);
    if (IN(7)) { PH_ARGS;
        pg8::Gemm g{proj + L1_H, Wt_out, MROWS, DM, INNER, PITCH, INNER, MAIN_W / 64, (L1_QM - (L1_H + MAIN_W)) * 2}; pg8::StaticOrder S; S.init(MROWS, DM, G, c);
        pg8::EpiRes E{out, out, DM}; pg8::gemm_phase<pg8::EpiRes, pg8::StaticOrder>((PG8_LAS unsigned char*)lds, g, S, E);
    }
    SEAM(7);
    if (IN(8)) { PH_ARGS;
        for (int row = c * 8 + wid; row < MROWS; row += G * 8) {
            float* xr = out + (size_t)row * DM; f32x4 y[4]; float ss = 0.f;
#pragma unroll
            for (int i = 0; i < 4; ++i) { y[i] = *(const f32x4*)(xr + 256 * i + 4 * lane); ss += y[i][0] * y[i][0] + y[i][1] * y[i][1] + y[i][2] * y[i][2] + y[i][3] * y[i][3]; }
            ss = wave_sum(ss); const float rs = 1.0f / sqrtf(ss * (1.0f / 1024.0f) + EPS);
#pragma unroll
            for (int i = 0; i < 4; ++i) { const f32x4 gg = *(const f32x4*)(final_g + 256 * i + 4 * lane); *(f32x4*)(xr + 256 * i + 4 * lane) = y[i] * rs * gg; }
        }
    }
#undef IN
#undef SEAM
}

extern "C" void kernel_launch(void* const* d_in, const int* in_sizes, int n_in, void* d_out, int out_size, void* d_ws, size_t ws_size, hipStream_t stream) {
    static int grid = 0;
    if (grid == 0) {
        if (n_in != 10 || ws_size < WS_END) { fprintf(stderr, "kernel_launch: unexpected n_in %d / ws_size %zu\n", n_in, ws_size); grid = -1; return; }
        int dev = 0, cus = 0, per_cu = 0;
        (void)hipGetDevice(&dev); (void)hipDeviceGetAttribute(&cus, hipDeviceAttributeMultiprocessorCount, dev);
        if (hipFuncSetAttribute((const void*)mk_fwd, hipFuncAttributeMaxDynamicSharedMemorySize, LDS_BYTES) != hipSuccess) { fprintf(stderr, "kernel_launch: hipFuncSetAttribute failed\n"); grid = -1; return; }
        if (hipOccupancyMaxActiveBlocksPerMultiprocessor(&per_cu, (const void*)mk_fwd, NTHR, LDS_BYTES) != hipSuccess || per_cu < 1) { fprintf(stderr, "kernel_launch: occupancy query gives %d\n", per_cu); per_cu = 1; }
        (void)hipGetLastError();
        grid = cus * 1;
    }
    if (grid < 0) return;
    Args a{};
    for (int i = 0; i < 10; ++i) a.in[i] = (const float*)d_in[i];
    a.out = (float*)d_out; a.ws = (unsigned char*)d_ws;
#if MK_MULTI_LAUNCH
    for (int p = 0; p < 9; ++p) { a.ph_lo = p; a.ph_hi = p + 1; hipLaunchKernelGGL(mk_fwd, dim3(grid), dim3(NTHR), LDS_BYTES, stream, a); }
#else
    a.ph_lo = 0; a.ph_hi = 9;
    (void)hipMemsetAsync((unsigned char*)d_ws + WS_CTL, 0, 16384, stream);
    void* kargs[] = {&a};
    hipError_t e = hipLaunchCooperativeKernel((const void*)mk_fwd, dim3(grid), dim3(NTHR), kargs, LDS_BYTES, stream);
    if (e != hipSuccess) fprintf(stderr, "kernel_launch: cooperative launch failed: %s (grid %d)\n", hipGetErrorString(e), grid);
#endif
}
```

```cpp
#include <hip/hip_runtime.h>
#include <hip/hip_bf16.h>
#include <hip/hip_cooperative_groups.h>
#include <cstdio>
#include <cstdint>
namespace cg = cooperative_groups;

#ifndef MK_MULTI_LAUNCH
#define MK_MULTI_LAUNCH 0
#endif

constexpr int NB = 8, SEQ = 2048, DM = 1024, MROWS = NB * SEQ;
constexpr int NH = 12, NHM = 4, HD = 128, NMEM = 256;
constexpr int MAIN_W = NH * HD, MEM_W = NHM * HD, INNER = MAIN_W + MEM_W;
constexpr int FOX_IN = 3 * MAIN_W + NH + MEM_W + INNER;
constexpr int RET_IN = 2 * NH * 64 + MAIN_W + MEM_W + INNER;
constexpr int PITCH = 7168;
constexpr int NPROJ0 = 7168, NPROJ1 = 5632;
constexpr int L0_Q = 0, L0_K = 1536, L0_V = 3072, L0_QM = 4608, L0_Z = 5120;
constexpr int L1_Q = 0, L1_K = 768, L1_V = 1536, L1_QM = 3072, L1_Z = 3584, L1_H = 5632;
constexpr float EPS = 1e-6f;
constexpr float SQRT_HD = 11.313708498984761f;

constexpr size_t MiB = 1u << 20;
constexpr size_t WS_WIN = 0, WS_WKV = 14 * MiB, WS_WOUT = 16 * MiB, WS_PROJ = 20 * MiB, WS_MEMN = 244 * MiB, WS_KVM = 248 * MiB,
                 WS_CS = 252 * MiB, WS_ROT = 252 * MiB + 768 * 1024, WS_CTL = 254 * MiB, WS_END = 254 * MiB + 16384;

typedef unsigned short bf16_t;
typedef short bf16x8 __attribute__((ext_vector_type(8)));
typedef short s16x4 __attribute__((ext_vector_type(4)));
typedef float f32x4 __attribute__((ext_vector_type(4)));
typedef float f32x16 __attribute__((ext_vector_type(16)));
typedef unsigned u32x4 __attribute__((ext_vector_type(4)));
typedef unsigned u32x2 __attribute__((ext_vector_type(2)));

__device__ __forceinline__ unsigned cvtpk(float lo, float hi) { unsigned r; asm volatile("v_cvt_pk_bf16_f32 %0, %1, %2" : "=v"(r) : "v"(lo), "v"(hi)); return r; }
template <int CTRL> __device__ __forceinline__ float dpp_xadd(float v) { return v + __builtin_bit_cast(float, __builtin_amdgcn_update_dpp(0, __builtin_bit_cast(int, v), CTRL, 0xf, 0xf, false)); }
__device__ __forceinline__ float bf2f(unsigned short b) { return __uint_as_float(((unsigned)b) << 16); }
__device__ __forceinline__ float silu_f(float z) { return z * __builtin_amdgcn_rcpf(1.0f + __builtin_amdgcn_exp2f(-1.4426950408889634f * z)); }

namespace pg8 {
#define PG8_LAS __attribute__((address_space(3)))
constexpr int BM = 256, BK = 64, HALF = 128, HTB = HALF * BK * 2, STAGE_BYTES = 8 * HTB, NXCD = 8, WGM = 8;
__host__ __device__ __forceinline__ int lds_byte(int r, int c) { const int st = (r >> 4) * 2 + (c >> 5), rr = r & 15, cc = c & 31, ob = rr * 64 + cc * 2; return st * 1024 + (ob ^ (((ob >> 9) & 1) << 5)); }
__host__ __device__ __forceinline__ void stage_rc(int b, int& R, int& C) { const int st = b / 1024, sb = b % 1024, swz = sb ^ (((sb >> 9) & 1) << 5); R = (st >> 1) * 16 + swz / 64; C = (st & 1) * 32 + (swz % 64) / 2; }
__host__ __device__ __forceinline__ int perm32(int rho) { const int n = rho >> 4, i = rho & 15; return 8 * (i >> 2) + 4 * n + (i & 3); }
struct Unit { int pm, pn; };
struct Gemm { const bf16_t* A; const bf16_t* Bt; int M, N, K, lda, ldb, kj_tile, kj_bytes; };
struct StaticOrder {
    int nM, nN, nwg, G, c, rep;
    __host__ __device__ void init(int M, int N, int G_, int c_, int rep_ = 1) { nM = M / BM; nN = N / BM; nwg = nM * nN; G = G_; c = c_; rep = rep_; }
    __host__ __device__ bool next(int i, Unit& u) const {
        const long L = (long)i * G + c; if (L >= (long)nwg * rep) return false;
        int wgid = (int)(L % nwg); { const int q = nwg / NXCD, r = nwg % NXCD, xcd = wgid % NXCD, off = wgid / NXCD; wgid = (xcd < r ? xcd * (q + 1) : r * (q + 1) + (xcd - r) * q) + off; }
        const int nig = WGM * nN, gid = wgid / nig, fm = gid * WGM, gsz = (nM - fm) < WGM ? (nM - fm) : WGM;
        u.pm = fm + ((wgid % nig) % gsz); u.pn = (wgid % nig) / gsz; return true;
    }
};
struct EpiBf16 {
    bf16_t* O; int ldc;
    __device__ __forceinline__ void operator()(const f32x4 (&acc)[2][2][4][2], const Unit& u, int wr, int wc, int fr, int fq) const {
        const int row0 = u.pm * BM + wr * 64 + fr; const int col0 = u.pn * BM + wc * 32 + 8 * fq;
#pragma unroll
        for (int ai = 0; ai < 2; ++ai)
#pragma unroll
            for (int m = 0; m < 4; ++m) { bf16_t* rowp = O + (size_t)(row0 + ai * HALF + m * 16) * ldc + col0;
#pragma unroll
                for (int bj = 0; bj < 2; ++bj) { const f32x4 v0 = acc[ai][bj][m][0], v1 = acc[ai][bj][m][1];
                    u32x4 w; w.x = cvtpk(v0[0], v0[1]); w.y = cvtpk(v0[2], v0[3]); w.z = cvtpk(v1[0], v1[1]); w.w = cvtpk(v1[2], v1[3]);
                    *(u32x4*)(rowp + bj * HALF) = w; } }
    }
};
struct EpiRot {
    bf16_t* O; int ldc; const float* rot;
    __device__ __forceinline__ void operator()(const f32x4 (&acc)[2][2][4][2], const Unit& u, int wr, int wc, int fr, int fq) const {
        const int row0 = u.pm * BM + wr * 64 + fr; const int col0 = u.pn * BM + wc * 32 + 8 * fq;
        const bool isrot = u.pn < 6; const float sc = (u.pn >= 3 && u.pn < 6) ? 0.125f : 1.0f;
        const int i0 = (wc & 1) * 16 + 4 * fq;
#pragma unroll
        for (int ai = 0; ai < 2; ++ai)
#pragma unroll
            for (int m = 0; m < 4; ++m) { const int row = row0 + ai * HALF + m * 16; bf16_t* rowp = O + (size_t)row * ldc + col0;
                f32x4 cs0 = {1.f, 0.f, 1.f, 0.f}, cs1 = {1.f, 0.f, 1.f, 0.f};
                if (isrot) { const float* rp = rot + ((size_t)(row & (SEQ - 1)) * 32 + i0) * 2; cs0 = *(const f32x4*)rp; cs1 = *(const f32x4*)(rp + 4); }
#pragma unroll
                for (int bj = 0; bj < 2; ++bj) { f32x4 v0 = acc[ai][bj][m][0], v1 = acc[ai][bj][m][1];
                    if (isrot) {
                        const float a0 = v0[0] * cs0[0] - v0[1] * cs0[1], b0 = v0[0] * cs0[1] + v0[1] * cs0[0];
                        const float a1 = v0[2] * cs0[2] - v0[3] * cs0[3], b1 = v0[2] * cs0[3] + v0[3] * cs0[2];
                        const float a2 = v1[0] * cs1[0] - v1[1] * cs1[1], b2 = v1[0] * cs1[1] + v1[1] * cs1[0];
                        const float a3 = v1[2] * cs1[2] - v1[3] * cs1[3], b3 = v1[2] * cs1[3] + v1[3] * cs1[2];
                        v0 = (f32x4){a0 * sc, b0 * sc, a1 * sc, b1 * sc}; v1 = (f32x4){a2 * sc, b2 * sc, a3 * sc, b3 * sc}; }
                    u32x4 w; w.x = cvtpk(v0[0], v0[1]); w.y = cvtpk(v0[2], v0[3]); w.z = cvtpk(v1[0], v1[1]); w.w = cvtpk(v1[2], v1[3]);
                    *(u32x4*)(rowp + bj * HALF) = w; } }
    }
};
struct EpiRes {
    const float* base; float* out; int ldc;
    __device__ __forceinline__ void operator()(const f32x4 (&acc)[2][2][4][2], const Unit& u, int wr, int wc, int fr, int fq) const {
        const int row0 = u.pm * BM + wr * 64 + fr; const int col0 = u.pn * BM + wc * 32 + 8 * fq;
#pragma unroll
        for (int ai = 0; ai < 2; ++ai)
#pragma unroll
            for (int m = 0; m < 4; ++m) { const size_t off = (size_t)(row0 + ai * HALF + m * 16) * ldc + col0;
#pragma unroll
                for (int bj = 0; bj < 2; ++bj) {
                    const f32x4 b0 = *(const f32x4*)(base + off + bj * HALF), b1 = *(const f32x4*)(base + off + bj * HALF + 4);
                    *(f32x4*)(out + off + bj * HALF) = b0 + acc[ai][bj][m][0]; *(f32x4*)(out + off + bj * HALF + 4) = b1 + acc[ai][bj][m][1]; } }
    }
};

template <class Epi, class Sched>
__device__ __forceinline__ void gemm_phase(PG8_LAS unsigned char* lds, const Gemm g, const Sched& S, const Epi& E) {
    const int tid = threadIdx.x, wid = __builtin_amdgcn_readfirstlane(tid >> 6), lane = tid & 63, wr = wid >> 2, wc = wid & 3, fr = lane & 15, fq = lane >> 4;
    const int K = g.K, nt = K / BK;
    unsigned voffA[2], voffB[2];
#pragma unroll
    for (int i = 0; i < 2; ++i) { int R, C; stage_rc(tid * 16 + i * 8192, R, C); const int Rb = (R & ~31) + perm32(R & 31);
        voffA[i] = (unsigned)(R * g.lda + C) * 2u; voffB[i] = (unsigned)(Rb * g.ldb + C) * 2u; }
    const size_t kstep = (size_t)(BK * 2);
    const size_t hstepA = (size_t)HALF * g.lda * 2, hstepB = (size_t)HALF * g.ldb * 2;
    const size_t tstepA = 2 * hstepA, tstepB = 2 * hstepB;
    const unsigned ldsw = (unsigned)wid * 1024u;
    const int aoff = lds_byte(wr * 64 + fr, fq * 8), boff = lds_byte(wc * 32 + fr, fq * 8);
    const int kjt = g.kj_tile; const size_t kjb = (size_t)(long)g.kj_bytes;
#define PG8_AK(t) ((size_t)(t) * kstep + (((t) >= kjt) ? kjb : (size_t)0))
#define PG8_SA(b, h) (((b) * 2 + (h)) * HTB)
#define PG8_SB(b, h) ((4 + (b) * 2 + (h)) * HTB)
#define PG8_STAGE(bufoff, gbase, voff) do { _Pragma("unroll") for (int _i = 0; _i < 2; ++_i) \
        __builtin_amdgcn_global_load_lds((const unsigned*)((const char*)(gbase) + (voff)[_i]), (PG8_LAS unsigned*)(lds + (bufoff) + ldsw + _i * 8192), 16, 0, 0); } while (0)
#define PG8_LDA(dst, b, h) do { _Pragma("unroll") for (int m = 0; m < 4; ++m) _Pragma("unroll") for (int k = 0; k < 2; ++k) dst[m][k] = *(const PG8_LAS bf16x8*)(lds + PG8_SA(b, h) + aoff + m * 2048 + k * 1024); } while (0)
#define PG8_LDB(dst, b, h) do { _Pragma("unroll") for (int n = 0; n < 2; ++n) _Pragma("unroll") for (int k = 0; k < 2; ++k) dst[n][k] = *(const PG8_LAS bf16x8*)(lds + PG8_SB(b, h) + boff + n * 2048 + k * 1024); } while (0)
#define PG8_MMA(ai, bj, At, Bt) do { __builtin_amdgcn_s_setprio(1); _Pragma("unroll") for (int m = 0; m < 4; ++m) _Pragma("unroll") for (int n = 0; n < 2; ++n) _Pragma("unroll") for (int k = 0; k < 2; ++k) \
        acc[ai][bj][m][n] = __builtin_amdgcn_mfma_f32_16x16x32_bf16(Bt[n][k], At[m][k], acc[ai][bj][m][n], 0, 0, 0); __builtin_amdgcn_s_setprio(0); } while (0)
#define PG8_WAIT_V(n) asm volatile("s_waitcnt vmcnt(" #n ")" ::: "memory")
#define PG8_WAIT_L(n) asm volatile("s_waitcnt lgkmcnt(" #n ")" ::: "memory")
#define PG8_BAR __builtin_amdgcn_s_barrier()
#define PG8_SCHED __builtin_amdgcn_sched_barrier(0)
    Unit cur, nxt; int ui = 0;
    if (!S.next(0, cur)) return;
    f32x4 acc[2][2][4][2];
#pragma unroll
    for (int a = 0; a < 2; ++a)
#pragma unroll
        for (int b = 0; b < 2; ++b)
#pragma unroll
            for (int m = 0; m < 4; ++m)
#pragma unroll
                for (int n = 0; n < 2; ++n) acc[a][b][m][n] = (f32x4){0.f, 0.f, 0.f, 0.f};
    bf16x8 At[4][2], B0[2][2], B1[2][2];
    const char* cA = (const char*)g.A + (size_t)cur.pm * tstepA; const char* cB = (const char*)g.Bt + (size_t)cur.pn * tstepB;
    PG8_STAGE(PG8_SB(0, 0), cB, voffB); PG8_STAGE(PG8_SB(0, 1), cB + hstepB, voffB); PG8_STAGE(PG8_SA(0, 0), cA, voffA); PG8_STAGE(PG8_SA(0, 1), cA + hstepA, voffA);
    if (wr == 1) PG8_BAR;
    PG8_WAIT_V(2); PG8_BAR;
    PG8_STAGE(PG8_SB(1, 0), cB + kstep, voffB); PG8_STAGE(PG8_SA(1, 0), cA + kstep, voffA); PG8_STAGE(PG8_SB(1, 1), cB + hstepB + kstep, voffB);
    PG8_WAIT_V(6); PG8_BAR;
    for (;;) {
        const bool has_next = S.next(ui + 1, nxt);
        const char* nA = has_next ? (const char*)g.A + (size_t)nxt.pm * tstepA : cA; const char* nB = has_next ? (const char*)g.Bt + (size_t)nxt.pn * tstepB : cB;
        for (int t = 0; t < nt; t += 2) {
            const bool last = (t == nt - 2);
            const char* a1 = cA + PG8_AK(t + 1);
            const char* a2 = last ? nA : cA + PG8_AK(t + 2); const char* b2 = last ? nB : cB + (size_t)(t + 2) * kstep;
            const char* a3 = a2 + kstep; const char* b3 = b2 + kstep;
            PG8_LDB(B0, 0, 0); PG8_LDB(B1, 0, 1); PG8_SCHED; PG8_LDA(At, 0, 0); PG8_STAGE(PG8_SA(1, 1), a1 + hstepA, voffA);
            PG8_WAIT_V(8); PG8_WAIT_L(0); PG8_BAR; PG8_MMA(0, 0, At, B0); PG8_MMA(0, 1, At, B1); PG8_BAR; PG8_SCHED;
            PG8_LDA(At, 0, 1); PG8_STAGE(PG8_SB(0, 0), b2, voffB); PG8_STAGE(PG8_SB(0, 1), b2 + hstepB, voffB); PG8_STAGE(PG8_SA(0, 0), a2, voffA);
            PG8_WAIT_V(8); PG8_WAIT_L(0); PG8_BAR; PG8_MMA(1, 0, At, B0); PG8_MMA(1, 1, At, B1); PG8_BAR; PG8_SCHED;
            PG8_LDB(B0, 1, 0); PG8_LDB(B1, 1, 1); PG8_SCHED; PG8_LDA(At, 1, 0); PG8_STAGE(PG8_SA(0, 1), a2 + hstepA, voffA);
            PG8_WAIT_V(8); PG8_WAIT_L(0); PG8_BAR; PG8_MMA(0, 0, At, B0); PG8_MMA(0, 1, At, B1); PG8_BAR; PG8_SCHED;
            PG8_LDA(At, 1, 1); PG8_STAGE(PG8_SB(1, 0), b3, voffB); PG8_STAGE(PG8_SB(1, 1), b3 + hstepB, voffB); PG8_STAGE(PG8_SA(1, 0), a3, voffA);
            PG8_WAIT_V(8); PG8_WAIT_L(0); PG8_BAR; PG8_MMA(1, 0, At, B0); PG8_MMA(1, 1, At, B1); PG8_BAR; PG8_SCHED;
        }
        if (wr == 0) PG8_BAR;
        E(acc, cur, wr, wc, fr, fq);
        if (!has_next) break;
#pragma unroll
        for (int a = 0; a < 2; ++a)
#pragma unroll
            for (int b = 0; b < 2; ++b)
#pragma unroll
                for (int m = 0; m < 4; ++m)
#pragma unroll
                    for (int n = 0; n < 2; ++n) acc[a][b][m][n] = (f32x4){0.f, 0.f, 0.f, 0.f};
        cur = nxt; cA = nA; cB = nB; ++ui;
        if (wr == 1) PG8_BAR;
    }
    PG8_WAIT_V(0);
    PG8_BAR;
#undef PG8_AK
#undef PG8_SA
#undef PG8_SB
#undef PG8_STAGE
#undef PG8_LDA
#undef PG8_LDB
#undef PG8_MMA
#undef PG8_WAIT_V
#undef PG8_WAIT_L
#undef PG8_BAR
#undef PG8_SCHED
}
}

namespace att {
constexpr int NW = 8, QBLK = 32, KVBLK = 64, QB = NW * QBLK, D = 128;
constexpr int SHM_V = KVBLK * D * 2, SHM_K = KVBLK * D * 2;
constexpr int OFF_WS = 2 * SHM_V + 2 * SHM_K, OFF_CS = OFF_WS + NW * 64 * 4, OFF_STG = OFF_CS + 2 * SEQ * 4, STG_LD = 132, LDS_BYTES = OFF_STG + NW * 16 * STG_LD * 4;
constexpr float SCALE = 0.08838834764831845f;
constexpr float THR = 8.f;
constexpr int LDQ = PITCH;
#define KSWZ(row, colB) ((row) * 256 + ((colB) ^ (((row) & 7) << 4)))
#define SBAR() __builtin_amdgcn_sched_barrier(0)
__device__ __forceinline__ int v_st(int k, int c) { const int kk = (k & ~0xC) | ((k & 4) << 1) | ((k & 8) >> 1); return ((kk >> 3) * 4 + (c >> 5)) * 512 + ((kk & 7) * 32 + (c & 31)) * 2; }
__device__ __forceinline__ int v_rd_base(int lane) { return ((lane & 3) << 3) | (((lane >> 2) & 3) << 6) | (((lane >> 4) & 1) << 5) | (((lane >> 5) & 1) << 8); }
constexpr int v_rd_off(int d0, int ks, int half) { return d0 * 512 + ks * 4096 + half * 2048; }
__device__ __forceinline__ int crow(int r, int hi) { return (r & 3) + 8 * (r >> 2) + 4 * hi; }
__device__ __forceinline__ bf16x8 load8(const bf16_t* p) { return *reinterpret_cast<const bf16x8*>(p); }
__device__ __forceinline__ void mask_tile(f32x16& p0, f32x16& p1, int dq) {
    const float NEG = -__builtin_inff();
#pragma unroll
    for (int r = 0; r < 16; ++r) {
        const int c = (r & 3) + 8 * (r >> 2);
        if (dq - c < 0) p0[r] = NEG;
        if (dq - c - 32 < 0) p1[r] = NEG;
    }
}
__device__ __forceinline__ void bias_tile(f32x16& p0, f32x16& p1, const float* cb, float cq) {
#pragma unroll
    for (int j = 0; j < 4; ++j) { const f32x4 c0 = *(const f32x4*)(cb + 8 * j), c1 = *(const f32x4*)(cb + 8 * j + 32);
#pragma unroll
        for (int i = 0; i < 4; ++i) { p0[4 * j + i] = (p0[4 * j + i] + cq) - c0[i]; p1[4 * j + i] = (p1[4 * j + i] + cq) - c1[i]; }
        SBAR(); }
}
__device__ __forceinline__ void decay_tile(f32x16& p0, f32x16& p1, int dq, float lg2, float g1, float g2, float g3, float g32, bool needmask) {
    const float e0 = lg2 * (float)dq;
#pragma unroll
    for (int j = 0; j < 4; ++j) { const float f0 = __builtin_amdgcn_exp2f(fmaf(-lg2, (float)(8 * j), e0)), f1 = f0 * g1, f2 = f0 * g2, f3 = f0 * g3;
        p0[4 * j + 0] *= f0; p0[4 * j + 1] *= f1; p0[4 * j + 2] *= f2; p0[4 * j + 3] *= f3;
        p1[4 * j + 0] *= f0 * g32; p1[4 * j + 1] *= f1 * g32; p1[4 * j + 2] *= f2 * g32; p1[4 * j + 3] *= f3 * g32; }
    if (needmask) {
#pragma unroll
        for (int r = 0; r < 16; ++r) { const int c = (r & 3) + 8 * (r >> 2); if (dq - c < 0) p0[r] = 0.f; if (dq - c - 32 < 0) p1[r] = 0.f; }
    }
}
__device__ __forceinline__ void partialSM(f32x16& p0, f32x16& p1, float& m_reg, float& mn, float& alpha) {
    float pmax = p0[0];
#pragma unroll
    for (int r = 1; r < 16; ++r) pmax = fmaxf(pmax, p0[r]);
#pragma unroll
    for (int r = 0; r < 16; ++r) pmax = fmaxf(pmax, p1[r]);
    { auto rr = __builtin_amdgcn_permlane32_swap(__float_as_uint(pmax), __float_as_uint(pmax), false, false);
      pmax = fmaxf(__uint_as_float(rr[0]), __uint_as_float(rr[1])); }
    constexpr float C2 = 1.4426950408889634f * SCALE;
    if (__builtin_expect(__all((pmax - m_reg) * SCALE <= THR), 1)) { mn = m_reg; alpha = 1.f; }
    else { mn = fmaxf(m_reg, pmax); alpha = __builtin_amdgcn_exp2f((m_reg - mn) * C2); m_reg = mn; }
    const float mnL = -mn * C2;
#pragma unroll
    for (int r = 0; r < 16; ++r) p0[r] = fmaf(p0[r], C2, mnL);
#pragma unroll
    for (int r = 0; r < 16; ++r) p1[r] = fmaf(p1[r], C2, mnL);
#pragma unroll
    for (int r = 0; r < 16; ++r) p0[r] = __builtin_amdgcn_exp2f(p0[r]);
}
#define PK4(P, B_, OUT) do { unsigned a0 = cvtpk(P[B_+0], P[B_+1]), a1 = cvtpk(P[B_+2], P[B_+3]);                          \
        unsigned b0 = cvtpk(P[B_+4], P[B_+5]), b1 = cvtpk(P[B_+6], P[B_+7]);                                             \
        auto r0 = __builtin_amdgcn_permlane32_swap(a0, b0, false, false); auto r1 = __builtin_amdgcn_permlane32_swap(a1, b1, false, false); \
        u32x4 w = {r0[0], r1[0], r0[1], r1[1]}; OUT = *reinterpret_cast<bf16x8*>(&w); } while (0)
template <bool SOFTMAX>
__device__ __forceinline__ void finishSM(f32x16& p0, f32x16& p1, float alpha, float& l_reg, bf16x8& pa0, bf16x8& pa1, bf16x8& pa2, bf16x8& pa3) {
    if (SOFTMAX) {
#pragma unroll
        for (int r = 0; r < 16; ++r) p1[r] = __builtin_amdgcn_exp2f(p1[r]);
        float ps = 0;
#pragma unroll
        for (int r = 0; r < 16; ++r) ps += p0[r];
#pragma unroll
        for (int r = 0; r < 16; ++r) ps += p1[r];
        { auto rr = __builtin_amdgcn_permlane32_swap(__float_as_uint(ps), __float_as_uint(ps), false, false);
          ps = __uint_as_float(rr[0]) + __uint_as_float(rr[1]); }
        l_reg = l_reg * alpha + ps;
    }
    PK4(p0, 0, pa0); PK4(p0, 8, pa1); PK4(p1, 0, pa2); PK4(p1, 8, pa3);
}
#undef PK4
template <int KB, int NQF>
__device__ __forceinline__ void qkt(f32x16& p0, f32x16& p1, const char* K_lds, int r32, int hi, const bf16x8* qr) {
    p0 = f32x16{}; p1 = f32x16{};
    const char* kb[4];
#pragma unroll
    for (int dd = 0; dd < 4; ++dd) kb[dd] = K_lds + KB * SHM_K + KSWZ(r32, (dd * 16 + hi * 8) * 2);
#pragma unroll
    for (int d0 = 0; d0 < NQF; ++d0) { const char* a = kb[d0 & 3] + (d0 >> 2) * 128;
        bf16x8 b0 = *reinterpret_cast<const bf16x8*>(a);
        bf16x8 b1 = *reinterpret_cast<const bf16x8*>(a + 32 * 256);
        p0 = __builtin_amdgcn_mfma_f32_32x32x16_bf16(b0, qr[d0], p0, 0, 0, 0);
        p1 = __builtin_amdgcn_mfma_f32_32x32x16_bf16(b1, qr[d0], p1, 0, 0, 0); }
}
template <int VB>
__device__ __forceinline__ void pv_tile(f32x16* o, int vb0, bf16x8 pa0, bf16x8 pa1, bf16x8 pa2, bf16x8 pa3) {
#define TRRD(dst, off) asm volatile("ds_read_b64_tr_b16 %0, %1 offset:%2" : "=&v"(dst) : "v"(vb0), "i"(off) : "memory")
#define PV_D0(d0) do { s16x4 l0, l1, l2, l3, h0, h1, h2, h3; constexpr int b_ = VB * SHM_V + v_rd_off(d0, 0, 0); \
        TRRD(l0, b_); TRRD(h0, b_ + 2048); TRRD(l1, b_ + 4096); TRRD(h1, b_ + 6144); TRRD(l2, b_ + 8192); TRRD(h2, b_ + 10240); TRRD(l3, b_ + 12288); TRRD(h3, b_ + 14336); \
        asm volatile("s_waitcnt lgkmcnt(0)" ::: "memory"); SBAR();   \
        o[d0] = __builtin_amdgcn_mfma_f32_32x32x16_bf16(pa0, (bf16x8){l0[0], l0[1], l0[2], l0[3], h0[0], h0[1], h0[2], h0[3]}, o[d0], 0, 0, 0);   \
        o[d0] = __builtin_amdgcn_mfma_f32_32x32x16_bf16(pa1, (bf16x8){l1[0], l1[1], l1[2], l1[3], h1[0], h1[1], h1[2], h1[3]}, o[d0], 0, 0, 0);   \
        o[d0] = __builtin_amdgcn_mfma_f32_32x32x16_bf16(pa2, (bf16x8){l2[0], l2[1], l2[2], l2[3], h2[0], h2[1], h2[2], h2[3]}, o[d0], 0, 0, 0);   \
        o[d0] = __builtin_amdgcn_mfma_f32_32x32x16_bf16(pa3, (bf16x8){l3[0], l3[1], l3[2], l3[3], h3[0], h3[1], h3[2], h3[3]}, o[d0], 0, 0, 0); } while (0)
    PV_D0(0); PV_D0(1); PV_D0(2); PV_D0(3);
#undef PV_D0
#undef TRRD
}

struct BlockRef { unsigned q, k, v, o, z, cs; int P0; float lg2; };
struct Seam { bf16x8 qr[8]; bf16x8 st_v0, st_v1, st_k0, st_k1; };
#define GLD8(base, off) (*(const bf16x8*)((const char*)(base) + (off)))
#define VMW() asm volatile("s_waitcnt vmcnt(0)" ::: "memory")
#define VMWN(n) asm volatile("s_waitcnt vmcnt(%0)" :: "i"(n) : "memory")
#define SLOAD_H(Kp, Vp, k0) do { S.st_v0 = GLD8((Vp) + (size_t)(k0) * (LDKV * 2), kvoff); S.st_v1 = GLD8((Vp) + (size_t)((k0) + 32) * (LDKV * 2), kvoff);              \
                         if (sc < DQ) { S.st_k0 = GLD8((Kp) + (size_t)(k0) * (LDKV * 2), kvoff); S.st_k1 = GLD8((Kp) + (size_t)((k0) + 32) * (LDKV * 2), kvoff); } } while (0)
#define SWRITE_HK(bf) do { if (sc < DQ) { *(bf16x8*)(K_lds + (bf) * SHM_K + kws) = S.st_k0; *(bf16x8*)(K_lds + (bf) * SHM_K + kws + 32 * 256) = S.st_k1; } } while (0)
#define SWRITE_HV(bf) do { *(bf16x8*)(V_lds + (bf) * SHM_V + vst0) = S.st_v0; *(bf16x8*)(V_lds + (bf) * SHM_V + vst0 + 8192) = S.st_v1; } while (0)
#define SWRITE_H(bf) do { SWRITE_HV(bf); SWRITE_HK(bf); } while (0)
template <int MODE>
__device__ __forceinline__ void mix_prime(const BlockRef& cur, const char* wsb, char* lds, Seam& S, const int tid) {
    constexpr int DQ = MODE == 2 ? 64 : 128, NQF = DQ / 16, LDKV = MODE == 1 ? 1024 : PITCH;
    const int wid = __builtin_amdgcn_readfirstlane(tid >> 6), lane = tid & 63, r32 = lane & 31, hi = lane >> 5;
    const int sr = tid >> 4, sc = (tid & 15) * 8, kws = KSWZ(sr, sc * 2); char* K_lds = lds + 2 * SHM_V;
    const unsigned qoff = (unsigned)(((wid * QBLK + r32) * LDQ + hi * 8) * 2), kvoff = (unsigned)((sr * LDKV + sc) * 2);
#pragma unroll
    for (int d0 = 0; d0 < NQF; ++d0) S.qr[d0] = GLD8(wsb + cur.q + d0 * 32, qoff);
    SLOAD_H(wsb + cur.k, wsb + cur.v, 0);
    if (MODE == 0) { const f32x4 c = *(const f32x4*)(wsb + cur.cs + tid * 16); *(f32x4*)((float*)(lds + OFF_CS) + tid * 4) = c; }
    VMW(); SWRITE_HK(0);
    __syncthreads();
}
template <int MODE>
__device__ __forceinline__ void mix_block(const BlockRef& cur, const BlockRef& nxt, const char* wsb, char* lds, Seam& S, int par, const int tid) {
    constexpr int DQ = MODE == 2 ? 64 : 128, NQF = DQ / 16, LDKV = MODE == 1 ? 1024 : PITCH; constexpr bool CAUSAL = MODE != 1, SOFTMAX = MODE != 2;
    const int wid = __builtin_amdgcn_readfirstlane(tid >> 6), lane = tid & 63, r32 = lane & 31, hi = lane >> 5;
    const int NT = CAUSAL ? cur.P0 / KVBLK + 4 : NMEM / KVBLK;
    const int qlo = cur.P0 + wid * QBLK, qm = qlo + r32 - 4 * hi;
    char* V_lds = lds; char* K_lds = lds + 2 * SHM_V;
    float* ws = (float*)(lds + OFF_WS) + wid * 64; float* li_l = ws, * al_l = ws + 32;
    const float* cs_cur = (const float*)(lds + OFF_CS) + par * SEQ; float* cs_nxt = (float*)(lds + OFF_CS) + (par ^ 1) * SEQ;
    float m_reg = -1e30f, l_reg = 0; f32x16 o[4] = {};
    const int sr = tid >> 4, sc = (tid & 15) * 8, vst0 = v_st(sr, sc), kws = KSWZ(sr, sc * 2);
    const int vb0 = (int)(uintptr_t)V_lds + v_rd_base(lane);
    const char* Kh = wsb + cur.k; const char* Vh = wsb + cur.v;
    const unsigned qoff = (unsigned)(((wid * QBLK + r32) * LDQ + hi * 8) * 2), kvoff = (unsigned)((sr * LDKV + sc) * 2), eoff = (unsigned)(((wid * QBLK + 4 * hi) * LDQ + r32) * 2);
    const float lg2 = cur.lg2;
    float g1 = 1.f, g2 = 1.f, g3 = 1.f, g32 = 1.f;
    if (MODE == 2) { g1 = __uint_as_float(__builtin_amdgcn_readfirstlane(__float_as_uint(__builtin_amdgcn_exp2f(-lg2)))); g2 = g1 * g1; g3 = g2 * g1;
        g32 = __uint_as_float(__builtin_amdgcn_readfirstlane(__float_as_uint(__builtin_amdgcn_exp2f(-32.f * lg2)))); }
#define RESC(a) do { if (SOFTMAX) { if (__any((a) < 1.f)) { if (hi == 0) al_l[r32] = (a); asm volatile("s_waitcnt lgkmcnt(0)" ::: "memory");              \
                     for (int d_ = 0; d_ < 4; ++d_) for (int r = 0; r < 16; ++r) o[d_][r] *= al_l[crow(r, hi)]; } } } while (0)
#define KBASE(t) ((t) * KVBLK)
#define SCORE_FIX(P0_, P1_, mnX, alX, t) do { const int kb_ = KBASE(t);                                                                    \
        if (MODE == 0) { bias_tile(P0_, P1_, cs_cur + kb_ + 4 * hi, cs_cur[qlo + r32]); }                                                      \
        if (MODE == 2) { decay_tile(P0_, P1_, qm - kb_, lg2, g1, g2, g3, g32, kb_ + KVBLK - 1 > qlo); }                            \
        else { if (CAUSAL && (kb_ + KVBLK - 1 > qlo)) mask_tile(P0_, P1_, qm - kb_); partialSM(P0_, P1_, m_reg, mnX, alX); } } while (0)
#define SEAM_K0() do { VMWN(NQF); SWRITE_HK(0); SBAR(); if (MODE == 0) { const f32x4 c_ = *(const f32x4*)(wsb + nxt.cs + tid * 16); *(f32x4*)(cs_nxt + tid * 4) = c_; } SBAR(); } while (0)
    f32x16 pA0, pA1, pB0, pB1; float mnA = 0, mnB = 0, alA = 1.f, alB = 1.f; bf16x8 pa0, pa1, pa2, pa3;
    SWRITE_HV(0); SBAR();
    if (NT > 1) { SLOAD_H(Kh, Vh, KBASE(1)); }
    SBAR(); qkt<0, NQF>(pA0, pA1, K_lds, r32, hi, S.qr);
    SCORE_FIX(pA0, pA1, mnA, alA, 0);
    if (NT > 1) { VMW(); SWRITE_H(1); }
    __syncthreads();
#define HALF_STEP(PX0, PX1, mnX, alX, PY0, PY1, alY, t, KB, VB, SB) do {                                                      \
        SBAR(); qkt<KB, NQF>(PX0, PX1, K_lds, r32, hi, S.qr);                                                                 \
        finishSM<SOFTMAX>(PY0, PY1, alY, l_reg, pa0, pa1, pa2, pa3); SBAR();                                                  \
        if ((t) + 1 < NT) { SLOAD_H(Kh, Vh, KBASE((t) + 1)); SBAR(); }                                                  \
        pv_tile<VB>(o, vb0, pa0, pa1, pa2, pa3); SCORE_FIX(PX0, PX1, mnX, alX, (t));                                          \
        __syncthreads();                                                                                                      \
        if ((t) + 1 < NT) { VMW(); SWRITE_H(SB); }                                                                            \
        RESC(alX); __syncthreads(); } while (0)
    for (int t = 1; t + 1 < NT; t += 2) {
        HALF_STEP(pB0, pB1, mnB, alB, pA0, pA1, alA, t, 1, 0, 0);
        HALF_STEP(pA0, pA1, mnA, alA, pB0, pB1, alB, t + 1, 0, 1, 1);
    }
    const bool even = (NT & 1) == 0;
    if (even) { SBAR(); qkt<1, NQF>(pB0, pB1, K_lds, r32, hi, S.qr); SBAR(); }
    SLOAD_H(wsb + nxt.k, wsb + nxt.v, 0);
    SBAR();
#pragma unroll
    for (int d0 = 0; d0 < NQF; ++d0) S.qr[d0] = GLD8(wsb + nxt.q + d0 * 32, qoff);
    SBAR();
    finishSM<SOFTMAX>(pA0, pA1, alA, l_reg, pa0, pa1, pa2, pa3); SBAR();
    pv_tile<0>(o, vb0, pa0, pa1, pa2, pa3);
    if (even) { SCORE_FIX(pB0, pB1, mnB, alB, NT - 1); __syncthreads(); RESC(alB);
        finishSM<SOFTMAX>(pB0, pB1, alB, l_reg, pa0, pa1, pa2, pa3); SBAR(); pv_tile<1>(o, vb0, pa0, pa1, pa2, pa3); }
    SBAR(); SEAM_K0();
    {
        float* stg = (float*)(lds + OFF_STG) + wid * (16 * STG_LD);
        if (SOFTMAX) { if (hi == 0) li_l[r32] = l_reg; }
        const int lr4 = lane >> 4, c8 = (lane & 15) * 8;
        const unsigned e2 = (unsigned)(((wid * QBLK + lr4) * LDQ + c8) * 2);
#pragma unroll
        for (int p = 0; p < 2; ++p) {
#pragma unroll
            for (int rr = 0; rr < 8; ++rr) { const int lr = (rr & 3) + 8 * (rr >> 2) + 4 * hi;
#pragma unroll
                for (int d0 = 0; d0 < 4; ++d0) stg[lr * STG_LD + d0 * 32 + r32] = o[d0][8 * p + rr]; }
            u32x4 zz[4];
#pragma unroll
            for (int i = 0; i < 4; ++i) zz[i] = *(const u32x4*)(wsb + cur.z + (size_t)(16 * p + 4 * i) * (LDQ * 2) + e2);
#pragma unroll
            for (int i = 0; i < 4; ++i) { const int lr = lr4 + 4 * i;
                const f32x4 a = *(const f32x4*)(stg + lr * STG_LD + c8), b = *(const f32x4*)(stg + lr * STG_LD + c8 + 4);
                float rn;
                if (SOFTMAX) rn = __builtin_amdgcn_rcpf(li_l[16 * p + lr]);
                else { float ss = (a[0] * a[0] + a[1] * a[1]) + (a[2] * a[2] + a[3] * a[3]) + (b[0] * b[0] + b[1] * b[1]) + (b[2] * b[2] + b[3] * b[3]);
                    ss = dpp_xadd<0xB1>(ss); ss = dpp_xadd<0x4E>(ss); ss = dpp_xadd<0x141>(ss); ss = dpp_xadd<0x140>(ss);
                    rn = __builtin_amdgcn_rsqf(ss * (1.0f / 128.0f) + EPS); }
                u32x4 w;
                w.x = cvtpk(a[0] * rn * silu_f(__uint_as_float(zz[i].x << 16)), a[1] * rn * silu_f(__uint_as_float(zz[i].x & 0xffff0000u)));
                w.y = cvtpk(a[2] * rn * silu_f(__uint_as_float(zz[i].y << 16)), a[3] * rn * silu_f(__uint_as_float(zz[i].y & 0xffff0000u)));
                w.z = cvtpk(b[0] * rn * silu_f(__uint_as_float(zz[i].z << 16)), b[1] * rn * silu_f(__uint_as_float(zz[i].z & 0xffff0000u)));
                w.w = cvtpk(b[2] * rn * silu_f(__uint_as_float(zz[i].w << 16)), b[3] * rn * silu_f(__uint_as_float(zz[i].w & 0xffff0000u)));
                *(u32x4*)((char*)wsb + cur.o + (size_t)(16 * p + 4 * i) * (LDQ * 2) + e2) = w; }
        }
    }
    __syncthreads();
#undef RESC
#undef KBASE
#undef SCORE_FIX
#undef SEAM_K0
#undef HALF_STEP
}
#undef GLD8
#undef VMW
#undef VMWN
#undef SLOAD_H
#undef SWRITE_HK
#undef SWRITE_HV
#undef SWRITE_H
}


#define XB_TMO      128
#define XB_XCNT(j)  (256  + 64 * (j))
#define XB_XSUB(j)  (1280 + 64 * (j))
#define XB_XGEN(j)  (2304 + 64 * (j))
#define XB_TOP      3328
#define XB_TOPGEN   3392
#define XCD_BAR_WORDS 3456
#define XB_SPIN_CAP (1u << 18)
#define LAS __attribute__((address_space(3)))
__device__ __forceinline__ unsigned xb_ld(unsigned* p)              { return __hip_atomic_load(p, __ATOMIC_RELAXED, __HIP_MEMORY_SCOPE_AGENT); }
__device__ __forceinline__ unsigned xb_add(unsigned* p, unsigned v) { return __hip_atomic_fetch_add(p, v, __ATOMIC_RELAXED, __HIP_MEMORY_SCOPE_AGENT); }
__device__ __forceinline__ unsigned xb_xcc_id() { return (unsigned)__builtin_amdgcn_s_getreg((3 << 11) | 20) & 0xFu; }
#define XB_SPIN(cond, bar) do { unsigned _sp = 0; while (cond) { __builtin_amdgcn_s_sleep(1); \
    if ((++_sp & 255u) == 0u) { if (xb_ld(&(bar)[XB_TMO])) break; if (_sp > XB_SPIN_CAP) { atomicAdd(&(bar)[XB_TMO], 1u); break; } } } } while (0)
struct XcdBarrier { unsigned* bar; unsigned x; volatile LAS unsigned* st; };
__device__ __forceinline__ XcdBarrier xcd_barrier_post(unsigned* bar, volatile LAS unsigned* st) {
    XcdBarrier b; b.bar = bar; b.x = xb_xcc_id(); b.st = st;
    if (threadIdx.x == 0) (void)xb_add(&bar[XB_XCNT(b.x)], 1u);
    return b;
}
__device__ __forceinline__ void xcd_barrier_complete(unsigned* bar, unsigned x, unsigned& nloc, unsigned& nx) {
    const unsigned G = gridDim.x * gridDim.y * gridDim.z;
    unsigned sum, cnt, mine, sp = 0u;
    for (;;) {
        sum = 0u; cnt = 0u; mine = 0u;
#pragma unroll
        for (unsigned j = 0; j < 16; ++j) { const unsigned c = xb_ld(&bar[XB_XCNT(j)]); sum += c; cnt += (c > 0u) ? 1u : 0u; mine = (j == x) ? c : mine; }
        if (sum == G) break;
        __builtin_amdgcn_s_sleep(1);
        if ((++sp & 255u) == 0u) { if (xb_ld(&bar[XB_TMO])) break; if (sp > XB_SPIN_CAP) { atomicAdd(&bar[XB_TMO], 1u); break; } }
    }
    nloc = mine > 0u ? mine : 1u; nx = cnt > 0u ? cnt : 1u;
}
__device__ __forceinline__ void xcd_barrier(const XcdBarrier& b) {
    asm volatile("s_waitcnt vmcnt(0)" ::: "memory");
    __syncthreads();
    if (threadIdx.x == 0) {
        unsigned* bar = b.bar;
        __builtin_amdgcn_s_waitcnt(0);
        unsigned nloc = b.st[0], nx = b.st[1];
        if (nloc == 0u) { xcd_barrier_complete(bar, b.x, nloc, nx); b.st[0] = nloc; b.st[1] = nx; }
        const unsigned old = xb_add(&bar[XB_XSUB(b.x)], 1u);
        const unsigned gen = old / nloc;
        if (old + 1u == (gen + 1u) * nloc) {
            __builtin_amdgcn_fence(__ATOMIC_RELEASE, "agent");
            asm volatile("s_waitcnt vmcnt(0)" ::: "memory");
            const unsigned og = xb_add(&bar[XB_TOP], 1u);
            const unsigned tg = og / nx;
            if (og + 1u == (tg + 1u) * nx) xb_add(&bar[XB_TOPGEN], 1u);
            else XB_SPIN(xb_ld(&bar[XB_TOPGEN]) == tg, bar);
            __builtin_amdgcn_fence(__ATOMIC_ACQUIRE, "agent");
            xb_add(&bar[XB_XGEN(b.x)], 1u);
            asm volatile("s_waitcnt vmcnt(0)" ::: "memory");
        } else {
            XB_SPIN(xb_ld(&bar[XB_XGEN(b.x)]) == gen, bar);
            __builtin_amdgcn_fence(__ATOMIC_ACQUIRE, "agent");
            asm volatile("s_waitcnt vmcnt(0)" ::: "memory");
        }
    }
    __syncthreads();
}
constexpr int NTHR = 512;
constexpr int LDS_BYTES = att::LDS_BYTES + 128;
static_assert(LDS_BYTES >= 131072 + 128 && LDS_BYTES <= 160 * 1024, "LDS budget");
struct Args { const float* in[10]; float* out; unsigned char* ws; int ph_lo, ph_hi; };

__device__ __forceinline__ float wave_sum(float v) {
    v = dpp_xadd<0xB1>(v); v = dpp_xadd<0x4E>(v); v = dpp_xadd<0x141>(v); v = dpp_xadd<0x140>(v);
    { auto r = __builtin_amdgcn_permlane16_swap(__float_as_uint(v), __float_as_uint(v), false, false); v = __uint_as_float(r[0]) + __uint_as_float(r[1]); }
    { auto r = __builtin_amdgcn_permlane32_swap(__float_as_uint(v), __float_as_uint(v), false, false); v = __uint_as_float(r[0]) + __uint_as_float(r[1]); }
    return v;
}
__device__ __forceinline__ void load_row(const float* xr, int lane, f32x4 (&y)[4]) {
#pragma unroll
    for (int i = 0; i < 4; ++i) y[i] = *(const f32x4*)(xr + 256 * i + 4 * lane);
}
__device__ __forceinline__ void rms_row(const float* g, bf16_t* outr, int lane, f32x4 (&y)[4]) {
    float ss = 0.f;
#pragma unroll
    for (int i = 0; i < 4; ++i) ss += y[i][0] * y[i][0] + y[i][1] * y[i][1] + y[i][2] * y[i][2] + y[i][3] * y[i][3];
    ss = wave_sum(ss);
    const float rs = 1.0f / sqrtf(ss * (1.0f / 1024.0f) + EPS);
#pragma unroll
    for (int i = 0; i < 4; ++i) { const f32x4 gg = *(const f32x4*)(g + 256 * i + 4 * lane); y[i] = y[i] * rs * gg;
        u32x2 w; w.x = cvtpk(y[i][0], y[i][1]); w.y = cvtpk(y[i][2], y[i][3]); *(u32x2*)(outr + 256 * i + 4 * lane) = w; }
}
template <int LAYER>
__device__ __forceinline__ void tile_addr(int id, int n, const float* w_in, const float* w_kv, const float* w_out, bf16_t* Wt_in, bf16_t* Wt_kv, bf16_t* Wt_out,
                                          const float*& src, int& ldw, bf16_t*& dst, int& K) {
    constexpr int NIN = LAYER == 0 ? NPROJ0 : NPROJ1, LDIN = LAYER == 0 ? FOX_IN : RET_IN;
    constexpr int T_IN = (DM / 128) * (NIN / 64), T_KV = (DM / 128) * (1024 / 64);
    if (id < T_IN) { const int k0 = (id & 7) * 128, n0 = (id >> 3) * 64, col = n0 + n; int sn;
        if (LAYER == 0) sn = col < 4608 ? col : col + 12;
        else { const int p = col & 63; sn = col >= 1536 ? col : (col & ~63) + (p & 1) * 32 + (p >> 1); }
        src = w_in + (size_t)k0 * LDIN + sn; ldw = LDIN; dst = Wt_in + (size_t)n0 * DM + k0; K = DM; }
    else if (id < T_IN + T_KV) { const int t = id - T_IN, k0 = (t & 7) * 128, n0 = (t >> 3) * 64;
        src = w_kv + (size_t)k0 * 1024 + n0 + n; ldw = 1024; dst = Wt_kv + (size_t)n0 * DM + k0; K = DM; }
    else { const int t = id - T_IN - T_KV, k0 = (t & 15) * 128, n0 = (t >> 4) * 64;
        src = w_out + (size_t)k0 * DM + n0 + n; ldw = DM; dst = Wt_out + (size_t)n0 * INNER + k0; K = INNER; }
}
template <int LAYER>
__device__ __forceinline__ void transpose_all(const float* w_in, const float* w_kv, const float* w_out, bf16_t* Wt_in, bf16_t* Wt_kv, bf16_t* Wt_out, float* tile, int G, int c) {
    constexpr int NIN = LAYER == 0 ? NPROJ0 : NPROJ1;
    constexpr int T = (DM / 128) * (NIN / 64) + (DM / 128) * (1024 / 64) + (INNER / 128) * (DM / 64);
    const int tid = threadIdx.x, n = tid & 63, kk = tid >> 6;
    int id = c; float v[16]; const float* src; int ldw, K; bf16_t* dst;
    if (id < T) { tile_addr<LAYER>(id, n, w_in, w_kv, w_out, Wt_in, Wt_kv, Wt_out, src, ldw, dst, K);
#pragma unroll
        for (int i = 0; i < 16; ++i) v[i] = src[(size_t)(kk + 8 * i) * ldw]; }
    while (id < T) {
        const int nid = id + G; float vn[16]; const float* nsrc; int nldw, nK = K; bf16_t* ndst = dst;
        if (nid < T) { tile_addr<LAYER>(nid, n, w_in, w_kv, w_out, Wt_in, Wt_kv, Wt_out, nsrc, nldw, ndst, nK);
#pragma unroll
            for (int i = 0; i < 16; ++i) vn[i] = nsrc[(size_t)(kk + 8 * i) * nldw]; }
        __syncthreads();
#pragma unroll
        for (int i = 0; i < 16; ++i) tile[(kk + 8 * i) * 65 + n] = v[i];
        __syncthreads();
        { const int k = (tid & 63) * 2, nn = tid >> 6;
#pragma unroll
          for (int i = 0; i < 8; ++i) { const int nc = nn + 8 * i; *(unsigned*)(dst + (size_t)nc * K + k) = cvtpk(tile[k * 65 + nc], tile[(k + 1) * 65 + nc]); } }
#pragma unroll
        for (int i = 0; i < 16; ++i) v[i] = vn[i];
        dst = ndst; K = nK; id = nid;
    }
}
__device__ __constant__ const unsigned char DEAL_MAIN[8][8] = {
    { 0 * 8 + 7, 0 * 8 + 5, 0xFF, 0xFF, 0xFF, 0xFF, 0xFF, 0xFF }, { 1 * 8 + 7, 1 * 8 + 5, 0xFF, 0xFF, 0xFF, 0xFF, 0xFF, 0xFF }, { 2 * 8 + 7, 2 * 8 + 5, 0xFF, 0xFF, 0xFF, 0xFF, 0xFF, 0xFF },
    { 0 * 8 + 6, 0 * 8 + 4, 0 * 8 + 1, 0xFF, 0xFF, 0xFF, 0xFF, 0xFF }, { 1 * 8 + 6, 1 * 8 + 4, 1 * 8 + 1, 0xFF, 0xFF, 0xFF, 0xFF, 0xFF }, { 2 * 8 + 6, 2 * 8 + 4, 2 * 8 + 1, 0xFF, 0xFF, 0xFF, 0xFF, 0xFF },
    { 0 * 8 + 3, 1 * 8 + 3, 0 * 8 + 2, 1 * 8 + 2, 0xFF, 0xFF, 0xFF, 0xFF }, { 2 * 8 + 3, 2 * 8 + 2, 0 * 8 + 0, 1 * 8 + 0, 2 * 8 + 0, 0xFF, 0xFF, 0xFF } };
__device__ __constant__ const unsigned char DEAL_MEM_N[8] = { 1, 1, 1, 1, 1, 1, 0, 2 };
__device__ __constant__ const unsigned char DEAL_MEM_S[8] = { 0, 1, 2, 3, 4, 5, 6, 6 };
template <int MODE>
__device__ __forceinline__ bool get_block(int layer, int G, int c, int k, att::BlockRef& r) {
    const bool tab = (G == 256); const int vcu = (c & 7) * 32 + (c >> 3), grp = vcu >> 3, slot = vcu & 7;
    if (MODE == 1) {
        int L;
        if (tab) { if (k >= DEAL_MEM_N[slot]) return false; L = grp * 8 + DEAL_MEM_S[slot] + k; }
        else { L = c + k * G; if (L >= NB * NHM * 8) return false; }
        const int qb = L & 7, hm = (L >> 3) & 3, b = L >> 5;
        const int qcol = (layer == 0 ? L0_QM : L1_QM) + hm * 128, zcol = (layer == 0 ? L0_Z : L1_Z) + MAIN_W + hm * 128;
        const unsigned rowoff = (unsigned)WS_PROJ + (unsigned)(b * SEQ + qb * 256) * (unsigned)(PITCH * 2);
        const unsigned kv = (unsigned)WS_KVM + (unsigned)(b * NMEM) * 2048u + hm * 256;
        r.q = rowoff + qcol * 2; r.o = r.q; r.z = rowoff + zcol * 2; r.k = kv; r.v = kv + 1024; r.cs = 0; r.P0 = 0; r.lg2 = 0.f;
        return true;
    } else {
        int bh, qb;
        if (tab) { if (k >= 8) return false; const unsigned e = DEAL_MAIN[slot][k]; if (e == 0xFFu) return false; bh = grp * 3 + (int)(e >> 3); qb = (int)(e & 7u); }
        else { const int item = c + (k >> 1) * G; if (item >= NB * NH * 4) return false; const int x = item & 3; bh = item >> 2; qb = (k & 1) ? 7 - x : x; }
        const int b = bh / NH, h = bh % NH;
        const unsigned rowb = (unsigned)WS_PROJ + (unsigned)(b * SEQ) * (unsigned)(PITCH * 2), row0 = rowb + (unsigned)(qb * 256) * (unsigned)(PITCH * 2);
        if (MODE == 0) {
            r.q = row0 + (L0_Q + h * 128) * 2; r.o = r.q; r.z = row0 + (L0_Z + h * 128) * 2;
            r.k = rowb + (L0_K + h * 128) * 2; r.v = rowb + (L0_V + h * 128) * 2;
            r.cs = (unsigned)WS_CS + (unsigned)bh * (SEQ * 4); r.lg2 = 0.f;
        } else {
            r.q = row0 + (L1_Q + h * 64) * 2; r.o = row0 + (L1_H + h * 128) * 2; r.z = row0 + (L1_Z + h * 128) * 2;
            r.k = rowb + (L1_K + h * 64) * 2; r.v = rowb + (L1_V + h * 128) * 2;
            r.cs = 0; r.lg2 = __uint_as_float(__builtin_amdgcn_readfirstlane(__float_as_uint(log1pf(-exp2f(-5.0f - (float)h)) * 1.4426950408889634f)));
        }
        r.P0 = qb * 256;
        return true;
    }
}
template <int MODE>
__device__ __forceinline__ void run_stream(int layer, int G, int c, const char* wsb, char* lds) {
    att::BlockRef cur, nxt; int k = 0;
    if (!get_block<MODE>(layer, G, c, 0, cur)) return;
    att::Seam S; int par = 0;
    int tid = threadIdx.x; asm volatile("" : "+v"(tid));
    att::mix_prime<MODE>(cur, wsb, lds, S, tid);
    for (;;) {
        const bool has = get_block<MODE>(layer, G, c, k + 1, nxt);
        if (!has) nxt = cur;
        att::mix_block<MODE>(cur, nxt, wsb, lds, S, par, tid);
        if (!has) break;
        cur = nxt; ++k; par ^= 1;
    }
}
__device__ __forceinline__ void p0_body(unsigned char* lds, int tid, int lane, int wid, int G, int c, const float* x, const float* mem, const float* norm_g, const float* fox_w_in,
                                        const float* fox_b_f, const float* mem_norm_g, const float* w_mem_kv, const float* w_out, bf16_t* h0, float* cs, bf16_t* memn, float* rot,
                                        bf16_t* Wt_in, bf16_t* Wt_kv, bf16_t* Wt_out) {
        float* Wf = (float*)lds;
        float* tile = (float*)(lds + 49152);
        for (int i = tid; i < 3 * 1024; i += NTHR) { const int k = i / 3, q = i % 3; const f32x4 w = *(const f32x4*)(fox_w_in + (size_t)k * FOX_IN + 4608 + 4 * q);
            Wf[(4 * q + 0) * 1024 + k] = w[0]; Wf[(4 * q + 1) * 1024 + k] = w[1]; Wf[(4 * q + 2) * 1024 + k] = w[2]; Wf[(4 * q + 3) * 1024 + k] = w[3]; }
        __syncthreads();
        { int row = c * 8 + wid; const int RS = G * 8; f32x4 nx[4], nx2[4];
          if (row < MROWS) load_row(x + (size_t)row * DM, lane, nx);
          if (row + RS < MROWS) load_row(x + (size_t)(row + RS) * DM, lane, nx2);
          for (; row < MROWS; row += RS) {
            f32x4 y[4];
#pragma unroll
            for (int i = 0; i < 4; ++i) { y[i] = nx[i]; nx[i] = nx2[i]; }
            if (row + 2 * RS < MROWS) load_row(x + (size_t)(row + 2 * RS) * DM, lane, nx2);
            rms_row(norm_g, h0 + (size_t)row * DM, lane, y);
            float myv = 0.f;
#pragma unroll
            for (int j = 0; j < 12; ++j) { float a = 0.f;
#pragma unroll
                for (int i = 0; i < 4; ++i) { const f32x4 w = *(const f32x4*)(Wf + j * 1024 + 256 * i + 4 * lane); a += y[i][0] * w[0] + y[i][1] * w[1] + y[i][2] * w[2] + y[i][3] * w[3]; }
                a = wave_sum(a); if (lane == j) myv = a; }
            if (lane < 12) { const float t = myv + fox_b_f[lane];
                const float ls = t >= 0.f ? -log1pf(expf(-t)) : t - log1pf(expf(t));
                const int b = row / SEQ, s = row % SEQ; cs[((size_t)b * NH + lane) * SEQ + s] = ls; }
          } }
        for (int row = c * 8 + wid; row < NB * NMEM; row += G * 8) { f32x4 y[4]; load_row(mem + (size_t)row * DM, lane, y); rms_row(mem_norm_g, memn + (size_t)row * DM, lane, y); }
        for (int i = c * NTHR + tid; i < SEQ * 32; i += G * NTHR) { const int pos = i >> 5, j = i & 31;
            const float inv = 1.0f / powf(10000.0f, (float)j / 32.0f); const float ang = (float)pos * inv;
            rot[2 * i] = cosf(ang); rot[2 * i + 1] = sinf(ang); }
        transpose_all<0>(fox_w_in, w_mem_kv, w_out, Wt_in, Wt_kv, Wt_out, tile, G, c);
        __syncthreads();
}
__device__ __forceinline__ void p4_body(unsigned char* lds, int tid, int lane, int wid, int G, int c, const float* out, const float* norm_g, const float* ret_w_in, const float* w_mem_kv,
                                        const float* w_out, bf16_t* proj, bf16_t* Wt_in, bf16_t* Wt_kv, bf16_t* Wt_out) {
        float* tile = (float*)(lds + 49152);
        { int row = c * 8 + wid; const int RS = G * 8; f32x4 nx[4], nx2[4];
          if (row < MROWS) load_row(out + (size_t)row * DM, lane, nx);
          if (row + RS < MROWS) load_row(out + (size_t)(row + RS) * DM, lane, nx2);
          for (; row < MROWS; row += RS) {
            f32x4 y[4];
#pragma unroll
            for (int i = 0; i < 4; ++i) { y[i] = nx[i]; nx[i] = nx2[i]; }
            if (row + 2 * RS < MROWS) load_row(out + (size_t)(row + 2 * RS) * DM, lane, nx2);
            rms_row(norm_g + DM, proj + (size_t)row * PITCH + L1_H, lane, y);
          } }
        transpose_all<1>(ret_w_in, w_mem_kv + (size_t)DM * 1024, w_out + (size_t)INNER * DM, Wt_in, Wt_kv, Wt_out, tile, G, c);
        __syncthreads();
}
__global__ void __launch_bounds__(NTHR, 2) mk_fwd(Args args) {
    extern __shared__ __attribute__((aligned(16))) unsigned char lds[];
    const int tid = threadIdx.x, lane = tid & 63, wid = __builtin_amdgcn_readfirstlane(tid >> 6);
    const int G = gridDim.x, c = blockIdx.x;
    typedef const __attribute__((address_space(4))) Args* KArgP;
    KArgP ap = (KArgP)__builtin_amdgcn_kernarg_segment_ptr();
#define PH_ARGS asm volatile("" : "+s"(ap)); unsigned char* ws = ap->ws; float* out = ap->out;                                                           \
    const float* x = ap->in[0]; const float* mem = ap->in[1]; const float* norm_g = ap->in[2]; const float* fox_w_in = ap->in[3]; const float* fox_b_f = ap->in[4]; \
    const float* ret_w_in = ap->in[5]; const float* mem_norm_g = ap->in[6]; const float* w_mem_kv = ap->in[7]; const float* w_out = ap->in[8]; const float* final_g = ap->in[9]; \
    bf16_t* Wt_in = (bf16_t*)(ws + WS_WIN); bf16_t* Wt_kv = (bf16_t*)(ws + WS_WKV); bf16_t* Wt_out = (bf16_t*)(ws + WS_WOUT);                              \
    bf16_t* proj = (bf16_t*)(ws + WS_PROJ); bf16_t* memn = (bf16_t*)(ws + WS_MEMN); bf16_t* kvm = (bf16_t*)(ws + WS_KVM);                                   \
    float* cs = (float*)(ws + WS_CS); float* rot = (float*)(ws + WS_ROT); bf16_t* h0 = (bf16_t*)out;                                                       \
    (void)x; (void)mem; (void)norm_g; (void)fox_w_in; (void)fox_b_f; (void)ret_w_in; (void)mem_norm_g; (void)w_mem_kv; (void)w_out; (void)final_g;       \
    (void)Wt_in; (void)Wt_kv; (void)Wt_out; (void)proj; (void)memn; (void)kvm; (void)cs; (void)rot; (void)h0
    const int lo = ap->ph_lo, hi_ = ap->ph_hi;
#ifndef PROBE_PHASE
#define PROBE_PHASE -1
#endif
#if PROBE_PHASE >= 0
#define REPS(k) for (int rep_ = 0; rep_ < ((k) == PROBE_PHASE ? 2 : 1); ++rep_)
#define DRY false
#else
#define REPS(k)
#define DRY false
#endif
#ifndef PH_MASK
#define PH_MASK 0x1ff
#endif
#define IN(k) (((PH_MASK >> (k)) & 1) && lo <= (k) && (k) < hi_)
    volatile LAS unsigned* bst = (volatile LAS unsigned*)((LAS unsigned char*)lds + (LDS_BYTES - 16));
    if (tid < 4) bst[tid] = 0u;
    __syncthreads();
    XcdBarrier xbar; xbar.bar = (unsigned*)(ap->ws + WS_CTL); xbar.x = 0; xbar.st = bst;
    if (IN(0) && IN(2)) xbar = xcd_barrier_post((unsigned*)(ap->ws + WS_CTL), bst);
#define SEAM(k) do { if (IN(k) && IN((k) + 1)) { if ((k) == 0) { cg::this_grid().sync(); } else { xcd_barrier(xbar); } } } while (0)

    if (IN(0)) { PH_ARGS;
        p0_body(lds, tid, lane, wid, G, c, x, mem, norm_g, fox_w_in, fox_b_f, mem_norm_g, w_mem_kv, w_out, h0, cs, memn, rot, Wt_in, Wt_kv, Wt_out);
        if (PROBE_PHASE == 0) p0_body(lds, tid, lane, wid, G, c, x, mem, norm_g, fox_w_in, fox_b_f, mem_norm_g, w_mem_kv, w_out, h0, cs, memn, rot, Wt_in, Wt_kv, Wt_out);
    }
    SEAM(0);
    if (IN(1)) { PH_ARGS;
        float* wt = (float*)lds;
        for (int seq = c; seq < NB * NH; seq += G) {
            float* p = cs + (size_t)seq * SEQ + tid * 4; f32x4 v = *(const f32x4*)p;
            v[1] += v[0]; v[2] += v[1]; v[3] += v[2];
            float tot = v[3], inc = tot;
#pragma unroll
            for (int d = 1; d < 64; d <<= 1) { const float n = __shfl_up(inc, d); if (lane >= d) inc += n; }
            __syncthreads();
            if (lane == 63) wt[wid] = inc;
            __syncthreads();
            float base = inc - tot; for (int w = 0; w < wid; ++w) base += wt[w];
            v = (v + base) * SQRT_HD; *(f32x4*)p = v;
        }
        __syncthreads();
        { pg8::Gemm g{h0, Wt_in, MROWS, NPROJ0, DM, DM, DM, 1 << 30, 0}; pg8::StaticOrder S; S.init(MROWS, NPROJ0, G, c, PROBE_PHASE == 1 ? 2 : 1);
          pg8::EpiBf16 E{proj, PITCH}; pg8::gemm_phase<pg8::EpiBf16, pg8::StaticOrder>((PG8_LAS unsigned char*)lds, g, S, E); }
        { pg8::Gemm g{memn, Wt_kv, NB * NMEM, 1024, DM, DM, DM, 1 << 30, 0}; pg8::StaticOrder S; S.init(NB * NMEM, 1024, G, c);
          pg8::EpiBf16 E{kvm, 1024}; pg8::gemm_phase<pg8::EpiBf16, pg8::StaticOrder>((PG8_LAS unsigned char*)lds, g, S, E); }
    }
    SEAM(1);
    if (IN(2)) { PH_ARGS;
#ifndef NO_M0
        run_stream<0>(0, G, c, (const char*)ws, (char*)lds);
#endif
#ifndef NO_M1
        run_stream<1>(0, G, c, (const char*)ws, (char*)lds);
#endif
    }
    SEAM(2);
    if (IN(3)) { PH_ARGS;
        pg8::Gemm g{proj + L0_Q, Wt_out, MROWS, DM, INNER, PITCH, INNER, MAIN_W / 64, (L0_QM - MAIN_W) * 2}; pg8::StaticOrder S; S.init(MROWS, DM, G, c, PROBE_PHASE == 3 ? 2 : 1);
        pg8::EpiRes E{x, out, DM}; pg8::gemm_phase<pg8::EpiRes, pg8::StaticOrder>((PG8_LAS unsigned char*)lds, g, S, E);
    }
    SEAM(3);
    if (IN(4)) { PH_ARGS;
        p4_body(lds, tid, lane, wid, G, c, out, norm_g, ret_w_in, w_mem_kv, w_out, proj, Wt_in, Wt_kv, Wt_out);
        if (PROBE_PHASE == 4) p4_body(lds, tid, lane, wid, G, c, out, norm_g, ret_w_in, w_mem_kv, w_out, proj, Wt_in, Wt_kv, Wt_out);
    }
    SEAM(4);
    if (IN(5)) { PH_ARGS;
        { pg8::Gemm g{proj + L1_H, Wt_in, MROWS, NPROJ1, DM, PITCH, DM, 1 << 30, 0}; pg8::StaticOrder S; S.init(MROWS, NPROJ1, G, c, PROBE_PHASE == 5 ? 2 : 1);
          pg8::EpiRot E{proj, PITCH, rot}; pg8::gemm_phase<pg8::EpiRot, pg8::StaticOrder>((PG8_LAS unsigned char*)lds, g, S, E); }
        { pg8::Gemm g{memn, Wt_kv, NB * NMEM, 1024, DM, DM, DM, 1 << 30, 0}; pg8::StaticOrder S; S.init(NB * NMEM, 1024, G, (c + G / 2) % G);
          pg8::EpiBf16 E{kvm, 1024}; pg8::gemm_phase<pg8::EpiBf16, pg8::StaticOrder>((PG8_LAS unsigned char*)lds, g, S, E); }
    }
    SEAM(5);
    if (IN(6)) { PH_ARGS;
#ifndef NO_M2
        if (PROBE_PHASE == 6) run_stream<2>(1, G, c, (const char*)ws, (char*)lds);
        run_stream<2>(1, G, c, (const char*)ws, (char*)lds);
#endif
#ifndef NO_M1
        run_stream<1>(1, G, c, (const char*)ws, (char*)lds);
#endif
    }
    SEAM(6);
    if (IN(7)) { PH_ARGS;
        pg8::Gemm g{proj + L1_H, Wt_out, MROWS, DM, INNER, PITCH, INNER, MAIN_W / 64, (L1_QM - (L1_H + MAIN_W)) * 2}; pg8::StaticOrder S; S.init(MROWS, DM, G, c);
        pg8::EpiRes E{out, out, DM}; pg8::gemm_phase<pg8::EpiRes, pg8::StaticOrder>((PG8_LAS unsigned char*)lds, g, S, E);
    }
    SEAM(7);
    if (IN(8)) { PH_ARGS;
        int row = c * 8 + wid; const int RS = G * 8; f32x4 nx[4], nx2[4];
        if (row < MROWS) load_row(out + (size_t)row * DM, lane, nx);
        if (row + RS < MROWS) load_row(out + (size_t)(row + RS) * DM, lane, nx2);
        for (; row < MROWS; row += RS) {
            float* xr = out + (size_t)row * DM; f32x4 y[4]; float ss = 0.f;
#pragma unroll
            for (int i = 0; i < 4; ++i) { y[i] = nx[i]; nx[i] = nx2[i]; }
            if (row + 2 * RS < MROWS) load_row(out + (size_t)(row + 2 * RS) * DM, lane, nx2);
#pragma unroll
            for (int i = 0; i < 4; ++i) ss += y[i][0] * y[i][0] + y[i][1] * y[i][1] + y[i][2] * y[i][2] + y[i][3] * y[i][3];
            ss = wave_sum(ss); const float rs = 1.0f / sqrtf(ss * (1.0f / 1024.0f) + EPS);
#pragma unroll
            for (int i = 0; i < 4; ++i) { const f32x4 gg = *(const f32x4*)(final_g + 256 * i + 4 * lane); *(f32x4*)(xr + 256 * i + 4 * lane) = y[i] * rs * gg; }
        }
    }
#undef IN
#undef SEAM
}

extern "C" void kernel_launch(void* const* d_in, const int* in_sizes, int n_in, void* d_out, int out_size, void* d_ws, size_t ws_size, hipStream_t stream) {
    static int grid = 0;
    if (grid == 0) {
        if (n_in != 10 || ws_size < WS_END) { fprintf(stderr, "kernel_launch: unexpected n_in %d / ws_size %zu\n", n_in, ws_size); grid = -1; return; }
        int dev = 0, cus = 0, per_cu = 0;
        (void)hipGetDevice(&dev); (void)hipDeviceGetAttribute(&cus, hipDeviceAttributeMultiprocessorCount, dev);
        if (hipFuncSetAttribute((const void*)mk_fwd, hipFuncAttributeMaxDynamicSharedMemorySize, LDS_BYTES) != hipSuccess) { fprintf(stderr, "kernel_launch: hipFuncSetAttribute failed\n"); grid = -1; return; }
        if (hipOccupancyMaxActiveBlocksPerMultiprocessor(&per_cu, (const void*)mk_fwd, NTHR, LDS_BYTES) != hipSuccess || per_cu < 1) { fprintf(stderr, "kernel_launch: occupancy query gives %d\n", per_cu); per_cu = 1; }
        (void)hipGetLastError();
        grid = cus * 1;
    }
    if (grid < 0) return;
    Args a{};
    for (int i = 0; i < 10; ++i) a.in[i] = (const float*)d_in[i];
    a.out = (float*)d_out; a.ws = (unsigned char*)d_ws;
#if MK_MULTI_LAUNCH
    for (int p = 0; p < 9; ++p) { a.ph_lo = p; a.ph_hi = p + 1; hipLaunchKernelGGL(mk_fwd, dim3(grid), dim3(NTHR), LDS_BYTES, stream, a); }
#else
    a.ph_lo = 0; a.ph_hi = 9;
    (void)hipMemsetAsync((unsigned char*)d_ws + WS_CTL, 0, 16384, stream);
    void* kargs[] = {&a};
    hipError_t e = hipLaunchCooperativeKernel((const void*)mk_fwd, dim3(grid), dim3(NTHR), kargs, LDS_BYTES, stream);
    if (e != hipSuccess) fprintf(stderr, "kernel_launch: cooperative launch failed: %s (grid %d)\n", hipGetErrorString(e), grid);
#endif
}
```
